# Optimizing an MI355X kernel written in HIP

```python
import math
import jax, jax.numpy as jnp
from jax import lax
import numpy as np

D_MODEL = 2048
BATCH = 32
SEQ = 256
DEPTH = 2
DEC_BATCH = 4
DEC_SEQ = 4096
PAST_LEN = 256

GRID_W = 64
HEAD_DIM = 128
N_HEADS_A = D_MODEL // (2 * HEAD_DIM)
N_HEADS_B = D_MODEL // (2 * HEAD_DIM)
WIDTH_A = N_HEADS_A * HEAD_DIM
WIDTH_B = N_HEADS_B * HEAD_DIM
NA_ROWS = 8
NA_COLS = 16
CONV_W = 3
CHUNK = 64
HEAD_DIM_C = 64
N_HEADS_C = D_MODEL // HEAD_DIM_C
N_KV_C = N_HEADS_C // 8
WINDOW = 128
Q_BLOCK = 128
D_FF = 4 * D_MODEL
ROPE_BASE = 10000.0
EPS = 1e-6
N_AB_LAYERS = (DEPTH + 1) // 2
N_C_LAYERS = DEPTH // 2
AB_SPLITS = [WIDTH_A, WIDTH_A, WIDTH_A, 3 * WIDTH_B, WIDTH_B, N_HEADS_B, N_HEADS_B, N_HEADS_B, N_HEADS_B]
AB_IN = sum(AB_SPLITS)
C_SPLITS = [N_HEADS_C * HEAD_DIM_C, N_KV_C * HEAD_DIM_C, N_KV_C * HEAD_DIM_C]
C_IN = sum(C_SPLITS)

kernel_name = 'hybrid_flow_prefix_trunk_step'


def split_cols(x, sizes):
    idx = np.cumsum(sizes)[:-1].tolist()
    return jnp.split(x, idx, axis=-1)


def rms_norm(x, g):
    xf = x.astype(jnp.float32)
    y = xf * lax.rsqrt(jnp.mean(xf * xf, axis=-1, keepdims=True) + EPS)
    return (y * g.astype(jnp.float32)).astype(x.dtype)


def l2norm(x):
    xf = x.astype(jnp.float32)
    return xf * lax.rsqrt(jnp.sum(xf * xf, axis=-1, keepdims=True) + EPS)


def ada_params(cond, w, b):
    m = jnp.dot(jax.nn.silu(cond), w) + b
    return jnp.split(m[:, None, :], 6, axis=-1)


def modulate(x, g, shift, scale):
    return rms_norm(x, g) * (1.0 + scale) + shift


def sq_relu_mlp(h, w1, w2):
    return jnp.dot(jnp.square(jax.nn.relu(jnp.dot(h, w1))), w2)


def axial_rope(x):
    b, t, h, d = x.shape
    nf = d // 4
    inv = ROPE_BASE ** (-jnp.arange(nf, dtype=jnp.float32) / nf)
    tok = jnp.arange(t)
    pos = jnp.stack([tok // GRID_W, tok % GRID_W], axis=-1).astype(jnp.float32)
    ang = pos[:, :, None] * inv
    cos = jnp.cos(ang)[None, :, None]
    sin = jnp.sin(ang)[None, :, None]
    xr = x.astype(jnp.float32).reshape(b, t, h, 2, 2, nf)
    x1, x2 = xr[..., 0, :], xr[..., 1, :]
    out = jnp.stack([x1 * cos - x2 * sin, x2 * cos + x1 * sin], axis=-2)
    return out.reshape(b, t, h, d).astype(x.dtype)


def context_attention(q, k, v, sink):
    b, L, hq, d = q.shape
    hkv = k.shape[2]
    g = hq // hkv
    nb = L // Q_BLOCK
    scale = d ** -0.5
    qb = jnp.moveaxis(q.reshape(b, nb, Q_BLOCK, hkv, g, d), 1, 0)

    def block(qi):
        s = jnp.einsum('bqkgd,bskd->bkgqs', qi, k).astype(jnp.float32) * scale
        if sink is not None:
            snk = jnp.broadcast_to(sink.astype(jnp.float32).reshape(1, hkv, g, 1, 1), s.shape[:-1] + (1,))
            s = jnp.concatenate([s, snk], axis=-1)
        p = jax.nn.softmax(s, axis=-1)[..., :L].astype(v.dtype)
        return jnp.einsum('bkgqs,bskd->bqkgd', p, v)

    o = lax.map(block, qb)
    return jnp.moveaxis(o, 0, 1).reshape(b, L, hq, d)


def neighbourhood_attention(q, k, v, ctx_k, ctx_v, rel_bias):
    b, t, h, d = q.shape
    rows = t // GRID_W
    kr = min(NA_ROWS, rows)
    kc = NA_COLS
    n_loc = kr * kc
    scale = d ** -0.5
    qg = q.reshape(b, rows, GRID_W, h, d)
    kg = k.reshape(b, rows, GRID_W, h, d)
    vg = v.reshape(b, rows, GRID_W, h, d)
    cols = jnp.arange(GRID_W)
    col_start = jnp.clip(cols - kc // 2, 0, GRID_W - kc)
    col_idx = col_start[:, None] + jnp.arange(kc)
    dc = col_idx - cols[:, None] + (NA_COLS - 1)
    row_ids = jnp.arange(rows)
    row_start = jnp.clip(row_ids - kr // 2, 0, rows - kr)

    def one_row(args):
        r, rs, q_r = args
        k_rows = lax.dynamic_slice_in_dim(kg, rs, kr, axis=1)
        v_rows = lax.dynamic_slice_in_dim(vg, rs, kr, axis=1)
        k_nb = k_rows[:, :, col_idx]
        v_nb = v_rows[:, :, col_idx]
        dr = rs + jnp.arange(kr) - r + (NA_ROWS - 1)
        bias = rel_bias.astype(jnp.float32)[:, dr[:, None, None], dc[None, :, :]]
        s_loc = jnp.einsum('bwhd,bxwchd->bhwxc', q_r, k_nb).astype(jnp.float32) * scale
        s_loc = (s_loc + bias.transpose(0, 2, 1, 3)[None]).reshape(b, h, GRID_W, n_loc)
        s_ctx = jnp.einsum('bwhd,bshd->bhws', q_r, ctx_k).astype(jnp.float32) * scale
        p = jax.nn.softmax(jnp.concatenate([s_loc, s_ctx], axis=-1), axis=-1).astype(v.dtype)
        p_loc = p[..., :n_loc].reshape(b, h, GRID_W, kr, kc)
        o = jnp.einsum('bhwxc,bxwchd->bwhd', p_loc, v_nb)
        return o + jnp.einsum('bhws,bshd->bwhd', p[..., n_loc:], ctx_v)

    o = lax.map(one_row, (row_ids, row_start, jnp.moveaxis(qg, 1, 0)))
    return jnp.moveaxis(o, 0, 1).reshape(b, t, h, d)


def windowed_attention(q, k, v, ctx_k, ctx_v, sink):
    b, t, hq, d = q.shape
    hkv = k.shape[2]
    g = hq // hkv
    nb = t // Q_BLOCK
    n_loc = 3 * Q_BLOCK
    n_ctx = ctx_k.shape[1]
    scale = d ** -0.5
    pad = ((0, 0), (Q_BLOCK, Q_BLOCK), (0, 0), (0, 0))
    kp = jnp.pad(k, pad)
    vp = jnp.pad(v, pad)
    qb = jnp.moveaxis(q.reshape(b, nb, Q_BLOCK, hkv, g, d), 1, 0)
    q_off = jnp.arange(Q_BLOCK)
    k_off = jnp.arange(n_loc) - Q_BLOCK
    band = jnp.abs(k_off[None, :] - q_off[:, None]) <= WINDOW
    sink_l = sink.astype(jnp.float32).reshape(1, hkv, g, 1, 1)

    def block(args):
        i, qi = args
        ki = lax.dynamic_slice_in_dim(kp, i * Q_BLOCK, n_loc, axis=1)
        vi = lax.dynamic_slice_in_dim(vp, i * Q_BLOCK, n_loc, axis=1)
        kpos = i * Q_BLOCK + k_off
        valid = band & ((kpos >= 0) & (kpos < t))[None, :]
        s_loc = jnp.einsum('bqkgd,bskd->bkgqs', qi, ki).astype(jnp.float32) * scale
        s_loc = jnp.where(valid, s_loc, -jnp.inf)
        s_ctx = jnp.einsum('bqkgd,bskd->bkgqs', qi, ctx_k).astype(jnp.float32) * scale
        s_snk = jnp.broadcast_to(sink_l, s_loc.shape[:-1] + (1,))
        p = jax.nn.softmax(jnp.concatenate([s_loc, s_ctx, s_snk], axis=-1), axis=-1).astype(v.dtype)
        o = jnp.einsum('bkgqs,bskd->bqkgd', p[..., :n_loc], vi)
        return o + jnp.einsum('bkgqs,bskd->bqkgd', p[..., n_loc:n_loc + n_ctx], ctx_v)

    o = lax.map(block, (jnp.arange(nb), qb))
    return jnp.moveaxis(o, 0, 1).reshape(b, t, hq, d)


def centred_depthwise_conv(x, w):
    pad = CONV_W // 2
    return lax.conv_general_dilated(x, w[:, None, :].astype(x.dtype), window_strides=(1,),
                                    padding=[(pad, pad)], dimension_numbers=('NWC', 'WIO', 'NWC'),
                                    feature_group_count=x.shape[-1])


def gated_delta_rule(q, k, v, beta, g, s0):
    b, L, h, dk = q.shape
    n = L // CHUNK

    def chunks(x):
        return jnp.moveaxis(x.reshape((b, n, CHUNK, h) + x.shape[3:]), 3, 1)

    q, k, v, beta, g = (chunks(a) for a in (q, k, v, beta, g))
    gc = jnp.cumsum(g, axis=-1)
    tri = jnp.tril(jnp.ones((CHUNK, CHUNK), dtype=bool))
    strict = jnp.tril(jnp.ones((CHUNK, CHUNK), dtype=bool), -1)
    decay = jnp.exp(jnp.where(tri, gc[..., :, None] - gc[..., None, :], -jnp.inf))
    kb = k * beta[..., None]
    m = jnp.where(strict, jnp.einsum('bhncd,bhnsd->bhncs', kb, k) * decay, 0.0)
    eye = jnp.eye(CHUNK, dtype=jnp.float32)
    t_inv = lax.linalg.triangular_solve(eye + m, jnp.broadcast_to(eye, m.shape), left_side=True,
                                        lower=True, unit_diagonal=True)
    u = jnp.einsum('bhncs,bhnsv->bhncv', t_inv, v * beta[..., None])
    w = jnp.einsum('bhncs,bhnsk->bhnck', t_inv, kb * jnp.exp(gc)[..., None])
    qk = jnp.einsum('bhncd,bhnsd->bhncs', q, k) * decay
    q_dec = q * jnp.exp(gc)[..., None]
    g_last = gc[..., -1:]
    k_dec = k * jnp.exp(g_last - gc)[..., None]
    c_dec = jnp.exp(g_last[..., 0])
    xs = tuple(jnp.moveaxis(a, 2, 0) for a in (u, w, qk, q_dec, k_dec, c_dec))

    def step(s, inp):
        u_i, w_i, qk_i, qd_i, kd_i, cd_i = inp
        v_new = u_i - jnp.einsum('bhck,bhkv->bhcv', w_i, s)
        o = jnp.einsum('bhck,bhkv->bhcv', qd_i, s) + jnp.einsum('bhcs,bhsv->bhcv', qk_i, v_new)
        s = s * cd_i[..., None, None] + jnp.einsum('bhck,bhcv->bhkv', kd_i, v_new)
        return s, o

    s_final, o = lax.scan(step, s0, xs)
    o = jnp.moveaxis(jnp.moveaxis(o, 0, 2), 1, 3)
    return o.reshape(b, L, h, v.shape[-1]), s_final


def deltanet_mixer(qkv, z, beta_f, beta_b, a_f, a_b, conv_w, a_log, dt_bias, onorm_g, s0_f, s0_b):
    b, L, _ = qkv.shape
    qkv = jax.nn.silu(centred_depthwise_conv(qkv, conv_w))
    q, k, v = jnp.split(qkv, 3, axis=-1)
    heads = lambda x: x.reshape(b, L, N_HEADS_B, HEAD_DIM)
    q = l2norm(heads(q)) * (HEAD_DIM ** -0.5)
    k = l2norm(heads(k))
    v = heads(v).astype(jnp.float32)

    def gates(beta_raw, a_raw, dr):
        beta = jax.nn.sigmoid(beta_raw.astype(jnp.float32))
        g = -jnp.exp(a_log[dr].astype(jnp.float32)) * jax.nn.softplus(
            a_raw.astype(jnp.float32) + dt_bias[dr].astype(jnp.float32))
        return beta, g

    bf, gf = gates(beta_f, a_f, 0)
    bb, gb = gates(beta_b, a_b, 1)
    flip = lambda x: jnp.flip(x, axis=1)
    o_f, s_f = gated_delta_rule(q, k, v, bf, gf, s0_f.astype(jnp.float32))
    o_b, s_b = gated_delta_rule(flip(q), flip(k), flip(v), flip(bb), flip(gb), s0_b.astype(jnp.float32))
    o = o_f + flip(o_b)
    o = rms_norm(o, onorm_g) * jax.nn.silu(heads(z).astype(jnp.float32))
    return o.reshape(b, L, WIDTH_B).astype(qkv.dtype), s_f, s_b


def ab_mixer(h, attend_a, s0_f, s0_b, w_in, w_out, conv_w, a_log, dt_bias, onorm_g):
    b, L, _ = h.shape
    qa, ka, va, qkv_b, z, bf, bb, af, ab = split_cols(jnp.dot(h, w_in), AB_SPLITS)
    hd = lambda x: x.reshape(b, L, N_HEADS_A, HEAD_DIM)
    qa, ka, va = hd(qa), hd(ka), hd(va)
    o_a = attend_a(qa, ka, va).reshape(b, L, WIDTH_A)
    o_b, s_f, s_b = deltanet_mixer(qkv_b, z, bf, bb, af, ab, conv_w, a_log, dt_bias, onorm_g, s0_f, s0_b)
    out = jnp.dot(jnp.concatenate([o_a, o_b.astype(o_a.dtype)], axis=-1), w_out)
    return out, ka, va, s_f, s_b


def c_mixer(h, attend, w_qkv, w_out):
    b, L, _ = h.shape
    q, k, v = split_cols(jnp.dot(h, w_qkv), C_SPLITS)
    q = q.reshape(b, L, N_HEADS_C, HEAD_DIM_C)
    k = k.reshape(b, L, N_KV_C, HEAD_DIM_C)
    v = v.reshape(b, L, N_KV_C, HEAD_DIM_C)
    o = attend(q, k, v).reshape(b, L, N_HEADS_C * HEAD_DIM_C)
    return jnp.dot(o, w_out), k, v


def setup_inputs(seed: int = 0) -> dict:
    key = jax.random.key(seed)
    ks = jax.random.split(key, 32)
    D = D_MODEL
    nrm = lambda kk, shape, s: jax.random.normal(kk, shape, jnp.float32) * s
    dt = jnp.exp(jax.random.uniform(ks[21], (N_AB_LAYERS, 2, N_HEADS_B), jnp.float32,
                                    minval=math.log(1e-3), maxval=math.log(1e-1)))
    return {
        'x_prompt': nrm(ks[0], (BATCH, SEQ, D), 1.0),
        'x_sample': nrm(ks[1], (DEC_BATCH, DEC_SEQ, D), 1.0),
        'cache_a_k': nrm(ks[2], (DEC_BATCH, N_AB_LAYERS, PAST_LEN, N_HEADS_A, HEAD_DIM), 1.0),
        'cache_a_v': nrm(ks[3], (DEC_BATCH, N_AB_LAYERS, PAST_LEN, N_HEADS_A, HEAD_DIM), 1.0),
        'state_b_fwd': nrm(ks[4], (DEC_BATCH, N_AB_LAYERS, N_HEADS_B, HEAD_DIM, HEAD_DIM), 0.3),
        'state_b_bwd': nrm(ks[5], (DEC_BATCH, N_AB_LAYERS, N_HEADS_B, HEAD_DIM, HEAD_DIM), 0.3),
        'cache_c_k': nrm(ks[6], (DEC_BATCH, N_C_LAYERS, PAST_LEN, N_KV_C, HEAD_DIM_C), 1.0),
        'cache_c_v': nrm(ks[7], (DEC_BATCH, N_C_LAYERS, PAST_LEN, N_KV_C, HEAD_DIM_C), 1.0),
        'c': nrm(ks[8], (DEC_BATCH, D), 1.0),
        'c_ctx': nrm(ks[9], (D,), 1.0),
        'w_ada': nrm(ks[10], (DEPTH, D, 6 * D), 0.5 * D ** -0.5),
        'b_ada': nrm(ks[11], (DEPTH, 6 * D), 0.02),
        'norm_mix': 1.0 + nrm(ks[12], (DEPTH, D), 0.02),
        'norm_mlp': 1.0 + nrm(ks[13], (DEPTH, D), 0.02),
        'w_mlp_in': nrm(ks[14], (DEPTH, D, D_FF), D ** -0.5),
        'w_mlp_out': nrm(ks[15], (DEPTH, D_FF, D), D_FF ** -0.5),
        'ab_w_in': nrm(ks[16], (N_AB_LAYERS, D, AB_IN), D ** -0.5),
        'ab_w_out': nrm(ks[17], (N_AB_LAYERS, WIDTH_A + WIDTH_B, D), (WIDTH_A + WIDTH_B) ** -0.5),
        'a_rel_bias': nrm(ks[18], (N_AB_LAYERS, N_HEADS_A, 2 * NA_ROWS - 1, 2 * NA_COLS - 1), 0.1),
        'b_conv': nrm(ks[19], (N_AB_LAYERS, CONV_W, 3 * WIDTH_B), CONV_W ** -0.5),
        'b_a_log': jnp.log(jax.random.uniform(ks[20], (N_AB_LAYERS, 2, N_HEADS_B), jnp.float32, minval=1.0, maxval=16.0)),
        'b_dt_bias': dt + jnp.log(-jnp.expm1(-dt)),
        'b_out_norm': 1.0 + nrm(ks[22], (N_AB_LAYERS, HEAD_DIM), 0.02),
        'c_w_qkv': nrm(ks[23], (N_C_LAYERS, D, C_IN), D ** -0.5),
        'c_w_out': nrm(ks[24], (N_C_LAYERS, N_HEADS_C * HEAD_DIM_C, D), (N_HEADS_C * HEAD_DIM_C) ** -0.5),
        'c_sink': nrm(ks[25], (N_C_LAYERS, N_HEADS_C), 0.5),
        'final_norm': 1.0 + nrm(ks[26], (D,), 0.02),
    }


def reference(x_prompt, x_sample, cache_a_k, cache_a_v, state_b_fwd, state_b_bwd, cache_c_k, cache_c_v,
              c, c_ctx, w_ada, b_ada, norm_mix, norm_mlp, w_mlp_in, w_mlp_out, ab_w_in, ab_w_out,
              a_rel_bias, b_conv, b_a_log, b_dt_bias, b_out_norm, c_w_qkv, c_w_out, c_sink, final_norm):
    xp, xs = x_prompt, x_sample
    cond_ctx = c_ctx[None, :]
    new_a_k, new_a_v, new_b_fwd, new_b_bwd, new_c_k, new_c_v = [], [], [], [], [], []
    for layer in range(DEPTH):
        j = layer // 2
        mod_p = ada_params(cond_ctx, w_ada[layer], b_ada[layer])
        mod_s = ada_params(c, w_ada[layer], b_ada[layer])
        hp = modulate(xp, norm_mix[layer], mod_p[0], mod_p[1])
        hs = modulate(xs, norm_mix[layer], mod_s[0], mod_s[1])
        if layer % 2 == 0:
            ab_w = (ab_w_in[j], ab_w_out[j], b_conv[j], b_a_log[j], b_dt_bias[j], b_out_norm[j])
            zeros = jnp.zeros((xp.shape[0], N_HEADS_B, HEAD_DIM, HEAD_DIM), jnp.float32)
            op, ka, va, sf, sb = ab_mixer(hp, lambda q, k, v: context_attention(q, k, v, None),
                                          zeros, zeros, *ab_w)
            rel, ck, cv = a_rel_bias[j], cache_a_k[:, j], cache_a_v[:, j]
            os_, _, _, _, _ = ab_mixer(hs, lambda q, k, v: neighbourhood_attention(q, k, v, ck, cv, rel),
                                       state_b_fwd[:, j], state_b_bwd[:, j], *ab_w)
            new_a_k.append(ka)
            new_a_v.append(va)
            new_b_fwd.append(sf.astype(xp.dtype))
            new_b_bwd.append(sb.astype(xp.dtype))
        else:
            sink, ck, cv = c_sink[j], cache_c_k[:, j], cache_c_v[:, j]
            op, kc, vc = c_mixer(hp, lambda q, k, v: context_attention(q, k, v, sink), c_w_qkv[j], c_w_out[j])
            os_, _, _ = c_mixer(hs, lambda q, k, v: windowed_attention(axial_rope(q), axial_rope(k), v, ck, cv, sink),
                                c_w_qkv[j], c_w_out[j])
            new_c_k.append(kc)
            new_c_v.append(vc)
        xp = xp + mod_p[2] * op
        xs = xs + mod_s[2] * os_
        xp = xp + mod_p[5] * sq_relu_mlp(modulate(xp, norm_mlp[layer], mod_p[3], mod_p[4]), w_mlp_in[layer], w_mlp_out[layer])
        xs = xs + mod_s[5] * sq_relu_mlp(modulate(xs, norm_mlp[layer], mod_s[3], mod_s[4]), w_mlp_in[layer], w_mlp_out[layer])
    y_prompt = rms_norm(xp, final_norm)
    y_sample = rms_norm(xs, final_norm)
    return (y_prompt, y_sample, jnp.stack(new_a_k, axis=1), jnp.stack(new_a_v, axis=1),
            jnp.stack(new_b_fwd, axis=1), jnp.stack(new_b_bwd, axis=1),
            jnp.stack(new_c_k, axis=1), jnp.stack(new_c_v, axis=1))
```

```cpp
#include <hip/hip_runtime.h>
#include <hip/hip_cooperative_groups.h>
#include <cstdio>
#include <cstring>
namespace cg = cooperative_groups;

typedef unsigned short bf16_t;
typedef short bf16x8 __attribute__((ext_vector_type(8)));
typedef float f32x4 __attribute__((ext_vector_type(4)));
typedef unsigned int u32;

#define DEV __device__ __forceinline__
#define BAR_LDS() asm volatile("s_waitcnt lgkmcnt(0)\n\ts_barrier" ::: "memory")
#ifndef PHASE_STOP
#define PHASE_STOP 99
#endif

constexpr int NT = 256;
constexpr int DM = 2048;
constexpr int NTOK = 24576;
constexpr int NPR = 8192;
constexpr int DFF = 8192;
constexpr int ABN = 7200, ABNP = 7424;
constexpr int HSMEM = 56 * 1024;
constexpr int STAGE_LDS = 131072;
constexpr int DYN_LDS = STAGE_LDS + 64;
DEV int opaque_htid() { int t = (int)(threadIdx.x & 255); asm volatile("" : "+v"(t)); return t; }
#define HTID (opaque_htid())
#define HALF_ID (__builtin_amdgcn_readfirstlane((int)(threadIdx.x >> 8)))

enum { I_XP = 0, I_XS, I_CAK, I_CAV, I_SBF, I_SBB, I_CCK, I_CCV, I_C, I_CCTX, I_WADA, I_BADA, I_NMIX, I_NMLP,
       I_WMI, I_WMO, I_ABWI, I_ABWO, I_RELB, I_CONV, I_ALOG, I_DTB, I_ONORM, I_CWQKV, I_CWO, I_SINK, I_FNORM };

constexpr size_t O_YP = 0, O_YS = 16777216, O_AK = 50331648, O_AV = 58720256, O_BF = 67108864, O_BB = 71303168,
                 O_CK = 75497472, O_CV = 77594624;

constexpr size_t SZ_ABIN = (size_t)ABNP * DM * 2, SZ_SQ = (size_t)DM * DM * 2, SZ_CQKV = (size_t)2560 * DM * 2,
                 SZ_MLP = (size_t)DFF * DM * 2;
constexpr size_t W_ABIN = 0;
constexpr size_t W_ABOUT = W_ABIN + SZ_ABIN;
constexpr size_t W_CQKV = W_ABOUT + SZ_SQ;
constexpr size_t W_COUT = W_CQKV + SZ_CQKV;
constexpr size_t W_MLPIN = W_COUT + SZ_SQ;
constexpr size_t W_MLPOUT = W_MLPIN + 2 * SZ_MLP;
constexpr size_t R1 = W_MLPOUT + 2 * SZ_MLP;
constexpr size_t SZ_R1 = (size_t)NTOK * DM * 2;
constexpr size_t R2 = R1 + SZ_R1;
constexpr size_t SZ_R2 = (size_t)NTOK * DFF * 2;
constexpr size_t R3 = R2 + SZ_R2;
constexpr size_t SM0 = R3 + SZ_R1;
constexpr size_t S_ADA = SM0;
constexpr size_t S_BAR = S_ADA + 2 * 5 * 12288 * 4;
constexpr size_t S_GATES = S_BAR + 8192;
constexpr size_t S_GC = S_GATES + (size_t)NTOK * 32 * 4;
constexpr size_t S_CKC = S_GC + (size_t)6144 * 64 * 4;
constexpr size_t S_CVTC = S_CKC + (size_t)4 * 4 * 256 * 64 * 2;
constexpr size_t S_CTR = S_CVTC + (size_t)4 * 4 * 256 * 64 * 2;
constexpr size_t WS_TOTAL = S_CTR + 1024;
constexpr size_t R2_PA = R2;
constexpr size_t R2_VTA = R2_PA + (size_t)NTOK * 2048 * 2;
constexpr size_t R2_PB = R2_VTA + (size_t)1024 * NTOK * 2;
constexpr size_t R2_PZ = R2_PB + (size_t)NTOK * 3072 * 2;
constexpr size_t R2_QK = R2_PZ + (size_t)NTOK * 1024 * 2;
constexpr size_t R2_QKC = R2;
constexpr size_t R2_VTC = R2_QKC + (size_t)NTOK * 2304 * 2;
constexpr size_t R1_QN = R1;
constexpr size_t R1_KNT = R1 + (size_t)NTOK * 1024 * 2;

struct Params { const float* in[27]; float* out; char* ws; };

DEV unsigned xcc_id() { return (unsigned)__builtin_amdgcn_s_getreg((3 << 11) | 20) & 7u; }
DEV void grid_barrier(unsigned* bar, unsigned k, unsigned n_here, unsigned n_xcc, unsigned xcc) {
    asm volatile("s_waitcnt vmcnt(0)" ::: "memory");
    __syncthreads();
    if (threadIdx.x < 64) {
        if (threadIdx.x == 0) {
            const unsigned old = __hip_atomic_fetch_add(bar + 64 * (8 + xcc), 1u, __ATOMIC_RELAXED, __HIP_MEMORY_SCOPE_AGENT);
            if (old + 1u == k * n_here) {
                __builtin_amdgcn_fence(__ATOMIC_RELEASE, "agent");
                asm volatile("s_waitcnt vmcnt(0)" ::: "memory");
                __hip_atomic_fetch_add(bar + 64 * 16, 1u, __ATOMIC_RELAXED, __HIP_MEMORY_SCOPE_AGENT);
            }
            unsigned spins = 0;
            while (__hip_atomic_load(bar + 64 * 16, __ATOMIC_RELAXED, __HIP_MEMORY_SCOPE_AGENT) < k * n_xcc && ++spins < (1u << 24)) __builtin_amdgcn_s_sleep(1);
        }
        __builtin_amdgcn_fence(__ATOMIC_ACQUIRE, "agent");
        asm volatile("s_waitcnt vmcnt(0)" ::: "memory");
    }
    __syncthreads();
}
DEV bf16_t f2bf(float f) { u32 u = __float_as_uint(f); u += 0x7fffu + ((u >> 16) & 1u); return (bf16_t)(u >> 16); }
DEV float bf2f(bf16_t h) { return __uint_as_float(((u32)h) << 16); }
typedef __bf16 bf16x2n __attribute__((ext_vector_type(2)));
DEV u32 pack2(float a, float b) { bf16x2n v; v[0] = (__bf16)a; v[1] = (__bf16)b; return __builtin_bit_cast(u32, v); }
DEV float bflo(u32 w) { return __uint_as_float(w << 16); }
DEV float bfhi(u32 w) { return __uint_as_float(w & 0xffff0000u); }
DEV f32x4 mfma16(bf16x8 a, bf16x8 b, f32x4 c) { return __builtin_amdgcn_mfma_f32_16x16x32_bf16(a, b, c, 0, 0, 0); }
DEV float siluf(float v) { return v / (1.f + __expf(-v)); }
DEV int cond_of(int row) { return row < NPR ? 0 : 1 + ((row - NPR) >> 12); }

DEV void ada_item(const Params& p, int item, char* smem) {
    const int tid = HTID;
    const int kq = item & 3, cb = (item >> 2) % 96, l = (item >> 2) / 96, n0 = cb * 128, kbase = kq * 512;
    float* sc = (float*)smem;
    BAR_LDS();
    for (int idx = tid; idx < 5 * 512; idx += NT) {
        const int ci = idx >> 9, k = kbase + (idx & 511);
        const float v = ci == 0 ? p.in[I_CCTX][k] : p.in[I_C][(ci - 1) * 2048 + k];
        sc[idx] = siluf(v);
    }
    BAR_LDS();
    const int cg4 = tid & 31, kg = tid >> 5;
    float acc[5][4];
#pragma unroll
    for (int ci = 0; ci < 5; ++ci) { acc[ci][0] = acc[ci][1] = acc[ci][2] = acc[ci][3] = 0.f; }
    const float* wp = p.in[I_WADA] + (size_t)l * 2048 * 12288 + (size_t)kbase * 12288 + n0 + 4 * cg4;
#pragma unroll 8
    for (int k = kg; k < 512; k += 8) {
        const float4 w = *(const float4*)(wp + (size_t)k * 12288);
#pragma unroll
        for (int ci = 0; ci < 5; ++ci) {
            const float sv = sc[ci * 512 + k];
            acc[ci][0] += sv * w.x; acc[ci][1] += sv * w.y; acc[ci][2] += sv * w.z; acc[ci][3] += sv * w.w;
        }
    }
    BAR_LDS();
    float* red = (float*)smem;
#pragma unroll
    for (int ci = 0; ci < 5; ++ci)
#pragma unroll
        for (int e = 0; e < 4; ++e) red[(kg * 5 + ci) * 128 + 4 * cg4 + e] = acc[ci][e];
    BAR_LDS();
    float* ada = (float*)(p.ws + S_ADA);
    for (int idx = tid; idx < 640; idx += NT) {
        const int ci = idx >> 7, c = idx & 127;
        float sum = (kq == 0) ? p.in[I_BADA][l * 12288 + n0 + c] : 0.f;
#pragma unroll
        for (int g = 0; g < 8; ++g) sum += red[(g * 5 + ci) * 128 + c];
        atomicAdd(ada + (size_t)(l * 5 + ci) * 12288 + n0 + c, sum);
    }
}

DEV void phase0(const Params& p, char* smem) {
    if (blockIdx.x == 0 && threadIdx.x < 128) ((int*)(p.ws + S_CTR))[threadIdx.x] = 0;
    for (int it = blockIdx.x * 2 + HALF_ID; it < 768; it += gridDim.x * 2) ada_item(p, it, smem);
    constexpr int T_ABIN = 16 * 116, T_SQ = 16 * 32, T_CQKV = 16 * 40, T_MLPIN = 16 * 128, T_MLPOUT = 64 * 32;
    constexpr int E1 = T_ABIN, E2 = E1 + T_SQ, E3 = E2 + T_CQKV, E4 = E3 + T_SQ, E5 = E4 + 2 * T_MLPIN, E6 = E5 + 2 * T_MLPOUT;
    static_assert((E6 & 1) == 0, "even tile count: both halves of a block run the same number of barriers");
    const int tid = HTID;
    float* T = (float*)smem;
    const float* src; bf16_t* dst; int K, N, kt, ntl;
#define TR_DECODE(t_) do { int t = (t_); \
        if (t < E1) { src = p.in[I_ABWI]; dst = (bf16_t*)(p.ws + W_ABIN); K = 2048; N = ABN; ntl = t % 116; kt = t / 116; } \
        else if (t < E2) { t -= E1; src = p.in[I_ABWO]; dst = (bf16_t*)(p.ws + W_ABOUT); K = 2048; N = 2048; ntl = t % 32; kt = t / 32; } \
        else if (t < E3) { t -= E2; src = p.in[I_CWQKV]; dst = (bf16_t*)(p.ws + W_CQKV); K = 2048; N = 2560; ntl = t % 40; kt = t / 40; } \
        else if (t < E4) { t -= E3; src = p.in[I_CWO]; dst = (bf16_t*)(p.ws + W_COUT); K = 2048; N = 2048; ntl = t % 32; kt = t / 32; } \
        else if (t < E5) { t -= E4; const int l = t / T_MLPIN; t -= l * T_MLPIN; src = p.in[I_WMI] + (size_t)l * 2048 * 8192; \
            dst = (bf16_t*)(p.ws + W_MLPIN + (size_t)l * SZ_MLP); K = 2048; N = 8192; ntl = t % 128; kt = t / 128; } \
        else { t -= E5; const int l = t / T_MLPOUT; t -= l * T_MLPOUT; src = p.in[I_WMO] + (size_t)l * 8192 * 2048; \
            dst = (bf16_t*)(p.ws + W_MLPOUT + (size_t)l * SZ_MLP); K = 8192; N = 2048; ntl = t % 32; kt = t / 32; } } while (0)
    float4 A0, A1, A2, A3, A4, A5, A6, A7, B0, B1, B2, B3, B4, B5, B6, B7;
    bf16_t* dA = nullptr; bf16_t* dB = nullptr; int KA = 0, KB = 0;
    const int lr = tid >> 4, lc = (tid & 15) * 4;
#define TR_LD1(rr, i_) do { const int n = ntl * 64 + lc; rr = make_float4(0.f, 0.f, 0.f, 0.f); \
        if (n < N) rr = *(const float4*)(src + (size_t)(kt * 128 + lr + 16 * (i_)) * N + n); } while (0)
#define TR_LOAD(S, t_) do { TR_DECODE(t_); TR_LD1(S##0, 0); TR_LD1(S##1, 1); TR_LD1(S##2, 2); TR_LD1(S##3, 3); TR_LD1(S##4, 4); TR_LD1(S##5, 5); TR_LD1(S##6, 6); TR_LD1(S##7, 7); \
        d##S = dst + (size_t)(ntl * 64) * K + kt * 128; K##S = K; } while (0)
#define TR_ST1(rr, i_) do { float* q = T + (lr + 16 * (i_)) * 65 + lc; q[0] = rr.x; q[1] = rr.y; q[2] = rr.z; q[3] = rr.w; } while (0)
#define TR_STEP(S) do { \
        BAR_LDS(); \
        TR_ST1(S##0, 0); TR_ST1(S##1, 1); TR_ST1(S##2, 2); TR_ST1(S##3, 3); TR_ST1(S##4, 4); TR_ST1(S##5, 5); TR_ST1(S##6, 6); TR_ST1(S##7, 7); \
        bf16_t* dcur = d##S; const int Kcur = K##S; \
        BAR_LDS(); \
        { const int tn = min(tcur + 2 * tstride, E6 - 1); TR_LOAD(S, tn); }        \
        _Pragma("unroll") for (int it = 0; it < 4; ++it) { \
            const int c = tid + 256 * it, n = c >> 4, kc = c & 15; \
            const float* t = T + (8 * kc) * 65 + n; \
            uint4 o; \
            o.x = pack2(t[0 * 65], t[1 * 65]); o.y = pack2(t[2 * 65], t[3 * 65]); \
            o.z = pack2(t[4 * 65], t[5 * 65]); o.w = pack2(t[6 * 65], t[7 * 65]); \
            *(uint4*)(dcur + (size_t)n * Kcur + 8 * kc) = o; } \
        tcur += tstride; } while (0)
    const int tstride = gridDim.x * 2;
    int tcur = blockIdx.x * 2 + HALF_ID;
    { const int t0 = min(tcur, E6 - 1); TR_LOAD(A, t0); const int t1 = min(tcur + tstride, E6 - 1); TR_LOAD(B, t1); }
    while (tcur < E6) {
        TR_STEP(A);
        if (tcur < E6) TR_STEP(B);
    }
#undef TR_STEP
#undef TR_DECODE
#undef TR_LD1
#undef TR_LOAD
#undef TR_ST1
    const int gtid = blockIdx.x * 512 + threadIdx.x, gstride = gridDim.x * 512;
    bf16_t* cKA = (bf16_t*)(p.out + O_CK);
    bf16_t* cVtA = cKA + (size_t)4 * 8 * 256 * 128;
    for (int idx = gtid; idx < 4 * 8 * 256 * 128; idx += gstride) {
        const int d = idx & 127, h = (idx >> 7) & 7, s = (idx >> 10) & 255, b = idx >> 18;
        cKA[((size_t)(b * 8 + h) * 256 + s) * 128 + d] = f2bf(p.in[I_CAK][idx]);
        cVtA[((size_t)(b * 8 + h) * 128 + d) * 256 + s] = f2bf(p.in[I_CAV][idx]);
    }
    bf16_t* cKC = (bf16_t*)(p.ws + S_CKC);
    bf16_t* cVtC = (bf16_t*)(p.ws + S_CVTC);
    for (int idx = gtid; idx < 4 * 4 * 256 * 64; idx += gstride) {
        const int d = idx & 63, h = (idx >> 6) & 3, s = (idx >> 8) & 255, b = idx >> 16;
        cKC[((size_t)(b * 4 + h) * 256 + s) * 64 + d] = f2bf(p.in[I_CCK][idx]);
        cVtC[((size_t)(b * 4 + h) * 64 + d) * 256 + s] = f2bf(p.in[I_CCV][idx]);
    }
}

template <bool INBF16>
DEV void modulate_phase(const float* __restrict__ x0, const float* __restrict__ x1, const bf16_t* __restrict__ xb, const float* __restrict__ g,
                        const float* __restrict__ ada_l, int shift_idx, bf16_t* __restrict__ hout) {
    int t_ = (int)threadIdx.x;
    asm volatile("" : "+v"(t_));
    const int lane = t_ & 63, wave = __builtin_amdgcn_readfirstlane(t_ >> 6);
    const int nw = gridDim.x * 8, rpw = (NTOK + nw - 1) / nw;
    const int rb = (blockIdx.x * 8 + wave) * rpw, re = min(NTOK, rb + rpw);
    if (rb >= re) return;
    float4 gp[8], sp[8];
    auto ldrow = [&](float4 (&v)[8], int row) __attribute__((always_inline)) {
        const float* xr = row < NPR ? x0 + (size_t)row * DM : x1 + (size_t)(row - NPR) * DM;
#pragma unroll
        for (int i = 0; i < 8; ++i) {
            if (INBF16) { const uint2 r = *(const uint2*)(xb + (size_t)row * DM + (i * 64 + lane) * 4); v[i] = make_float4(bflo(r.x), bfhi(r.x), bflo(r.y), bfhi(r.y)); }
            else v[i] = *(const float4*)(xr + (i * 64 + lane) * 4);
        }
    };
    float4 vn[8];
    ldrow(vn, rb);
    int row = rb;
#pragma unroll 1
    while (row < re) {
      const int cond = cond_of(row);
      const int seg_end = min(re, cond == 0 ? NPR : NPR + 4096 * cond);
      {
        const float* sh = ada_l + (size_t)cond * 12288 + shift_idx * 2048;
#pragma unroll
        for (int i = 0; i < 8; ++i) {
            const int c = (i * 64 + lane) * 4;
            const float4 gg = *(const float4*)(g + c), c4 = *(const float4*)(sh + 2048 + c);
            sp[i] = *(const float4*)(sh + c);
            gp[i] = make_float4(gg.x * (1.f + c4.x), gg.y * (1.f + c4.y), gg.z * (1.f + c4.z), gg.w * (1.f + c4.w));
        }
      }
#pragma unroll 1
      for (; row < seg_end; ++row) {
        float4 v[8];
#pragma unroll
        for (int i = 0; i < 8; ++i) v[i] = vn[i];
        ldrow(vn, min(row + 1, re - 1));
        float ss = 0.f;
#pragma unroll
        for (int i = 0; i < 8; ++i) ss += v[i].x * v[i].x + v[i].y * v[i].y + v[i].z * v[i].z + v[i].w * v[i].w;
#pragma unroll
        for (int o = 32; o >= 1; o >>= 1) ss += __shfl_xor(ss, o);
        const float rstd = rsqrtf(ss * (1.f / 2048.f) + 1e-6f);
#pragma unroll
        for (int i = 0; i < 8; ++i) {
            const int c = (i * 64 + lane) * 4;
            uint2 o;
            o.x = pack2(v[i].x * rstd * gp[i].x + sp[i].x, v[i].y * rstd * gp[i].y + sp[i].y);
            o.y = pack2(v[i].z * rstd * gp[i].z + sp[i].z, v[i].w * rstd * gp[i].w + sp[i].w);
            *(uint2*)(hout + (size_t)row * DM + c) = o;
        }
      }
    }
}

DEV void final_norm_phase(const bf16_t* __restrict__ xb, float* __restrict__ x, const float* __restrict__ g) {
    const int lane = threadIdx.x & 63, wave = threadIdx.x >> 6;
    for (int row = blockIdx.x * 8 + wave; row < NTOK; row += gridDim.x * 8) {
        float* xr = x + (size_t)row * DM;
        float4 v[8];
        float ss = 0.f;
#pragma unroll
        for (int i = 0; i < 8; ++i) {
            { const uint2 r = *(const uint2*)(xb + (size_t)row * DM + (i * 64 + lane) * 4); v[i] = make_float4(bflo(r.x), bfhi(r.x), bflo(r.y), bfhi(r.y)); }
            ss += v[i].x * v[i].x + v[i].y * v[i].y + v[i].z * v[i].z + v[i].w * v[i].w;
        }
#pragma unroll
        for (int o = 32; o >= 1; o >>= 1) ss += __shfl_xor(ss, o);
        const float rstd = rsqrtf(ss * (1.f / 2048.f) + 1e-6f);
#pragma unroll
        for (int i = 0; i < 8; ++i) {
            const int c = (i * 64 + lane) * 4;
            const float4 gg = *(const float4*)(g + c);
            float4 o;
            o.x = v[i].x * rstd * gg.x; o.y = v[i].y * rstd * gg.y; o.z = v[i].z * rstd * gg.z; o.w = v[i].w * rstd * gg.w;
            *(float4*)(xr + c) = o;
        }
    }
}

#define LAS __attribute__((address_space(3)))
namespace g8 {
constexpr int BM = 256, BK = 64, HALF = 128, HTB = HALF * BK * 2, NXCD = 8, WGM = 8;
DEV int lds_byte(int r, int c) { const int st = (r >> 4) * 2 + (c >> 5), rr = r & 15, cc = c & 31, ob = rr * 64 + cc * 2; return st * 1024 + (ob ^ (((ob >> 9) & 1) << 5)); }
DEV void stage_rc(int b, int& R, int& C) { const int st = b / 1024, sb = b % 1024, swz = sb ^ (((sb >> 9) & 1) << 5); R = (st >> 1) * 16 + swz / 64; C = (st & 1) * 32 + (swz % 64) / 2; }
DEV int perm32(int rho) { const int n = rho >> 4, i = rho & 15; return 8 * (i >> 2) + 4 * n + (i & 3); }
struct Unit { int pm, pn; };
struct Order {
    int nM, nN, nwg, G, c;
    DEV void init(int M, int N, int G_, int c_) { nM = M / BM; nN = N / BM; nwg = nM * nN; G = G_; c = c_; }
    DEV bool next(int i, Unit& u) const {
        const long L = (long)i * G + c; if (L >= nwg) return false;
        int wgid = (int)L; { const int q = nwg / NXCD, r = nwg % NXCD, xcd = wgid % NXCD, off = wgid / NXCD; wgid = (xcd < r ? xcd * (q + 1) : r * (q + 1) + (xcd - r) * q) + off; }
        const int nig = WGM * nN, gid = wgid / nig, fm = gid * WGM, gsz = (nM - fm) < WGM ? (nM - fm) : WGM;
        u.pm = fm + ((wgid % nig) % gsz); u.pn = (wgid % nig) / gsz; return true;
    }
};
typedef f32x4 Acc[2][2][4][2];

template <class Epi>
DEV void gemm_phase(LAS unsigned char* lds, const bf16_t* __restrict__ A, const bf16_t* __restrict__ Bt, int M, int N, int K, const Epi& E) {
    int tid = threadIdx.x;
    asm volatile("" : "+v"(tid));
    const int wid = __builtin_amdgcn_readfirstlane(tid >> 6), lane = tid & 63, wr = wid >> 2, wc = wid & 3, fr = lane & 15, fq = lane >> 4;
    const int nt = K / BK;
    Order S; S.init(M, N, (int)gridDim.x, (int)blockIdx.x);
    unsigned voffA[2], voffB[2];
#pragma unroll
    for (int i = 0; i < 2; ++i) { int R, C; stage_rc(tid * 16 + i * 8192, R, C); const int Rb = Epi::PERM ? ((R & ~31) + perm32(R & 31)) : R;
        voffA[i] = (unsigned)(R * K + C) * 2u; voffB[i] = (unsigned)(Rb * K + C) * 2u; }
    const size_t kstep = (size_t)(BK * 2);
    const size_t hstep = (size_t)HALF * K * 2;
    const size_t tstep = 2 * hstep;
    const unsigned ldsw = (unsigned)wid * 1024u;
    const int aoff = lds_byte(wr * 64 + fr, fq * 8), boff = lds_byte(wc * 32 + fr, fq * 8);
#define G8_SA(b, h) (((b) * 2 + (h)) * HTB)
#define G8_SB(b, h) ((4 + (b) * 2 + (h)) * HTB)
#define G8_STAGE_(bufoff, gbase, voff) do { _Pragma("unroll") for (int _i = 0; _i < 2; ++_i) \
        __builtin_amdgcn_global_load_lds((const unsigned*)((const char*)(gbase) + (voff)[_i]), (LAS unsigned*)(lds + (bufoff) + ldsw + _i * 8192), 16, 0, 0); } while (0)
#define G8_STAGE(bufoff, gbase) G8_STAGE_(bufoff, gbase, voffA)
#define G8_STAGEB(bufoff, gbase) G8_STAGE_(bufoff, gbase, voffB)
#define G8_LDA(dst, b, h) do { _Pragma("unroll") for (int m = 0; m < 4; ++m) _Pragma("unroll") for (int k = 0; k < 2; ++k) dst[m][k] = *(const LAS bf16x8*)(lds + G8_SA(b, h) + aoff + m * 2048 + k * 1024); } while (0)
#define G8_LDB(dst, b, h) do { _Pragma("unroll") for (int n = 0; n < 2; ++n) _Pragma("unroll") for (int k = 0; k < 2; ++k) dst[n][k] = *(const LAS bf16x8*)(lds + G8_SB(b, h) + boff + n * 2048 + k * 1024); } while (0)
#define G8_MMA(ai, bj, At, Bt_) do { __builtin_amdgcn_s_setprio(1); _Pragma("unroll") for (int m = 0; m < 4; ++m) _Pragma("unroll") for (int n = 0; n < 2; ++n) _Pragma("unroll") for (int k = 0; k < 2; ++k) \
        acc[ai][bj][m][n] = __builtin_amdgcn_mfma_f32_16x16x32_bf16(Bt_[n][k], At[m][k], acc[ai][bj][m][n], 0, 0, 0); __builtin_amdgcn_s_setprio(0); } while (0)
#define G8_WAIT_V(n) asm volatile("s_waitcnt vmcnt(" #n ")" ::: "memory")
#define G8_WAIT_L(n) asm volatile("s_waitcnt lgkmcnt(" #n ")" ::: "memory")
#define G8_BAR __builtin_amdgcn_s_barrier()
#define G8_SCHED __builtin_amdgcn_sched_barrier(0)
    Unit cur, nxt; int ui = 0;
    if (!S.next(0, cur)) return;
    Acc acc;
#pragma unroll
    for (int a = 0; a < 2; ++a)
#pragma unroll
        for (int b = 0; b < 2; ++b)
#pragma unroll
            for (int m = 0; m < 4; ++m)
#pragma unroll
                for (int n = 0; n < 2; ++n) acc[a][b][m][n] = (f32x4){0.f, 0.f, 0.f, 0.f};
    bf16x8 At[4][2], B0[2][2], B1[2][2];
    const char* cA = (const char*)A + (size_t)cur.pm * tstep; const char* cB = (const char*)Bt + (size_t)cur.pn * tstep;
    G8_STAGEB(G8_SB(0, 0), cB); G8_STAGE(G8_SA(0, 0), cA); G8_STAGEB(G8_SB(0, 1), cB + hstep); G8_STAGE(G8_SA(0, 1), cA + hstep);
    if (wr == 1) G8_BAR;
    G8_WAIT_V(4); G8_BAR;
    G8_STAGEB(G8_SB(1, 0), cB + kstep); G8_STAGE(G8_SA(1, 0), cA + kstep); G8_STAGEB(G8_SB(1, 1), cB + hstep + kstep);
    G8_WAIT_V(6); G8_BAR;
    for (;;) {
        const bool has_next = S.next(ui + 1, nxt);
        const char* nA = has_next ? (const char*)A + (size_t)nxt.pm * tstep : cA; const char* nB = has_next ? (const char*)Bt + (size_t)nxt.pn * tstep : cB;
        for (int t = 0; t < nt; t += 2) {
            const bool last = (t == nt - 2);
            const char* a1 = cA + (size_t)(t + 1) * kstep;
            const char* a2 = last ? nA : cA + (size_t)(t + 2) * kstep; const char* b2 = last ? nB : cB + (size_t)(t + 2) * kstep;
            const char* a3 = a2 + kstep; const char* b3 = b2 + kstep;
            G8_LDB(B0, 0, 0); G8_SCHED; G8_LDA(At, 0, 0); G8_STAGE(G8_SA(1, 1), a1 + hstep);
            G8_WAIT_L(8); G8_BAR; G8_WAIT_L(0); G8_MMA(0, 0, At, B0); G8_BAR; G8_SCHED;
            G8_LDB(B1, 0, 1); G8_STAGEB(G8_SB(0, 0), b2);
            G8_BAR; G8_WAIT_L(0); G8_MMA(0, 1, At, B1); G8_BAR;
            G8_LDA(At, 0, 1); G8_STAGE(G8_SA(0, 0), a2);
            G8_BAR; G8_WAIT_L(0); G8_MMA(1, 0, At, B0); G8_BAR; G8_SCHED;
            G8_STAGEB(G8_SB(0, 1), b2 + hstep);
            G8_WAIT_V(6); G8_BAR; G8_MMA(1, 1, At, B1); G8_BAR;
            G8_LDB(B0, 1, 0); G8_SCHED; G8_LDA(At, 1, 0); G8_STAGE(G8_SA(0, 1), a2 + hstep);
            G8_WAIT_L(8); G8_BAR; G8_WAIT_L(0); G8_MMA(0, 0, At, B0); G8_BAR; G8_SCHED;
            G8_LDB(B1, 1, 1); G8_STAGEB(G8_SB(1, 0), b3);
            G8_BAR; G8_WAIT_L(0); G8_MMA(0, 1, At, B1); G8_BAR;
            G8_LDA(At, 1, 1); G8_STAGE(G8_SA(1, 0), a3);
            G8_BAR; G8_WAIT_L(0); G8_MMA(1, 0, At, B0); G8_BAR; G8_SCHED;
            G8_STAGEB(G8_SB(1, 1), b3 + hstep);
            G8_WAIT_V(6); G8_BAR; G8_MMA(1, 1, At, B1); G8_BAR;
        }
        E(acc, cur, wr, wc, fr, fq);
        if (!has_next) break;
#pragma unroll
        for (int a = 0; a < 2; ++a)
#pragma unroll
            for (int b = 0; b < 2; ++b)
#pragma unroll
                for (int m = 0; m < 4; ++m)
#pragma unroll
                    for (int n = 0; n < 2; ++n) acc[a][b][m][n] = (f32x4){0.f, 0.f, 0.f, 0.f};
        cur = nxt; cA = nA; cB = nB; ++ui;
    }
    G8_WAIT_V(0);
    if (wr == 0) G8_BAR;
    G8_BAR;
#undef G8_SA
#undef G8_SB
#undef G8_STAGE
#undef G8_STAGEB
#undef G8_STAGE_
#undef G8_LDA
#undef G8_LDB
#undef G8_MMA
#undef G8_WAIT_V
#undef G8_WAIT_L
#undef G8_BAR
#undef G8_SCHED
}
}

#define EPI_LOOP_ROWS for (int ai = 0; ai < 2; ++ai) _Pragma("unroll") for (int m = 0; m < 4; ++m)
#define EPI_LOOP_COLS for (int bj = 0; bj < 2; ++bj) _Pragma("unroll") for (int n = 0; n < 2; ++n)
struct EpiProj0 {
    static constexpr bool PERM = true;
    bf16_t* PA; bf16_t* VtA; bf16_t* PB; bf16_t* PZ; float* gates; float* nak; float* nav;
    DEV void operator()(const g8::Acc& acc, const g8::Unit& u, int wr, int wc, int fr, int fq) const {
        const int colt = u.pn * 256 + wc * 32 + 8 * fq;
#pragma unroll
        EPI_LOOP_ROWS {
            const int row = u.pm * 256 + ai * 128 + wr * 64 + m * 16 + fr;
#pragma unroll
            for (int bj = 0; bj < 2; ++bj) {
                const int col = colt + bj * 128;
                const f32x4 v0 = acc[ai][bj][m][0], v1 = acc[ai][bj][m][1];
                uint4 o; o.x = pack2(v0[0], v0[1]); o.y = pack2(v0[2], v0[3]); o.z = pack2(v1[0], v1[1]); o.w = pack2(v1[2], v1[3]);
                if (col < 2048) {
                    *(uint4*)(PA + (size_t)row * 2048 + col) = o;
                    if (col >= 1024 && row < NPR) { float* d = nak + (size_t)row * 1024 + (col - 1024); *(f32x4*)d = v0; *(f32x4*)(d + 4) = v1; }
                } else if (col < 3072) {
#pragma unroll
                    for (int j = 0; j < 4; ++j) { VtA[(size_t)(col - 2048 + j) * NTOK + row] = f2bf(v0[j]); VtA[(size_t)(col - 2048 + 4 + j) * NTOK + row] = f2bf(v1[j]); }
                    if (row < NPR) { float* d = nav + (size_t)row * 1024 + (col - 2048); *(f32x4*)d = v0; *(f32x4*)(d + 4) = v1; }
                } else if (col < 6144) {
                    *(uint4*)(PB + (size_t)row * 3072 + (col - 3072)) = o;
                } else if (col < 7168) {
                    *(uint4*)(PZ + (size_t)row * 1024 + (col - 6144)) = o;
                } else if (col < ABN) {
                    float* d = gates + (size_t)row * 32 + (col - 7168); *(f32x4*)d = v0; *(f32x4*)(d + 4) = v1;
                }
            }
        }
    }
};
template <bool INF32>
struct EpiRes {
    static constexpr bool PERM = true;
    const float* xin0; const float* xin1; const bf16_t* xbin; bf16_t* xbout; const float* gate;
    DEV void operator()(const g8::Acc& acc, const g8::Unit& u, int wr, int wc, int fr, int fq) const {
        const int colt = u.pn * 256 + wc * 32 + 8 * fq;
#pragma unroll
        EPI_LOOP_ROWS {
            const int row = u.pm * 256 + ai * 128 + wr * 64 + m * 16 + fr;
            const float* xr = row < NPR ? xin0 + (size_t)row * DM : xin1 + (size_t)(row - NPR) * DM;
            const float* gr = gate + (size_t)cond_of(row) * 12288;
#pragma unroll
            for (int bj = 0; bj < 2; ++bj) {
                const int col = colt + bj * 128;
                f32x4 x0, x1;
                if (INF32) { x0 = *(const f32x4*)(xr + col); x1 = *(const f32x4*)(xr + col + 4); }
                else { const uint4 r = *(const uint4*)(xbin + (size_t)row * DM + col);
                    x0 = (f32x4){bflo(r.x), bfhi(r.x), bflo(r.y), bfhi(r.y)}; x1 = (f32x4){bflo(r.z), bfhi(r.z), bflo(r.w), bfhi(r.w)}; }
                const f32x4 g0 = *(const f32x4*)(gr + col), g1 = *(const f32x4*)(gr + col + 4);
                const f32x4 r0 = x0 + g0 * acc[ai][bj][m][0], r1 = x1 + g1 * acc[ai][bj][m][1];
                uint4 o; o.x = pack2(r0[0], r0[1]); o.y = pack2(r0[2], r0[3]); o.z = pack2(r1[0], r1[1]); o.w = pack2(r1[2], r1[3]);
                *(uint4*)(xbout + (size_t)row * DM + col) = o;
            }
        }
    }
};
struct EpiMlp1 {
    static constexpr bool PERM = true;
    bf16_t* H;
    DEV void operator()(const g8::Acc& acc, const g8::Unit& u, int wr, int wc, int fr, int fq) const {
        const int colt = u.pn * 256 + wc * 32 + 8 * fq;
#pragma unroll
        EPI_LOOP_ROWS {
            const int row = u.pm * 256 + ai * 128 + wr * 64 + m * 16 + fr;
#pragma unroll
            for (int bj = 0; bj < 2; ++bj) {
                f32x4 v0 = acc[ai][bj][m][0], v1 = acc[ai][bj][m][1];
#pragma unroll
                for (int j = 0; j < 4; ++j) { const float r0 = fmaxf(v0[j], 0.f), r1 = fmaxf(v1[j], 0.f); v0[j] = r0 * r0; v1[j] = r1 * r1; }
                uint4 o; o.x = pack2(v0[0], v0[1]); o.y = pack2(v0[2], v0[3]); o.z = pack2(v1[0], v1[1]); o.w = pack2(v1[2], v1[3]);
                *(uint4*)(H + (size_t)row * DFF + colt + bj * 128) = o;
            }
        }
    }
};
struct EpiQkv1 {
    static constexpr bool PERM = false;
    bf16_t* QK; bf16_t* VtC; float* nck; float* ncv;
    DEV void operator()(const g8::Acc& acc, const g8::Unit& u, int wr, int wc, int fr, int fq) const {
        float inv[4];
#pragma unroll
        for (int j = 0; j < 4; ++j) inv[j] = exp2f(-(float)(fq * 4 + j) * 0.830482023721841f) * 0.15915494309189535f;
#pragma unroll
        EPI_LOOP_ROWS {
            const int row = u.pm * 256 + ai * 128 + wr * 64 + m * 16 + fr;
            const bool sample = row >= NPR;
            const int tok = (row - NPR) & 4095;
            const float pos = (float)((wc & 1) ? (tok & 63) : (tok >> 6));
#pragma unroll
            for (int bj = 0; bj < 2; ++bj) {
                const int cb = u.pn * 256 + bj * 128 + wc * 32 + 4 * fq;
                const f32x4 v0 = acc[ai][bj][m][0], v1 = acc[ai][bj][m][1];
                if (cb < 2304) {
                    if (!sample && cb >= 2048) {
                        *(f32x4*)(nck + (size_t)row * 256 + (cb - 2048)) = v0;
                        *(f32x4*)(nck + (size_t)row * 256 + (cb - 2048) + 16) = v1;
                    }
                    f32x4 o0 = v0, o1 = v1;
                    if (sample) {
#pragma unroll
                        for (int j = 0; j < 4; ++j) {
                            float rev = pos * inv[j];
                            rev -= floorf(rev);
                            const float sn = __builtin_amdgcn_sinf(rev), cs = __builtin_amdgcn_cosf(rev);
                            o0[j] = v0[j] * cs - v1[j] * sn;
                            o1[j] = v1[j] * cs + v0[j] * sn;
                        }
                    }
                    uint2 w0, w1; w0.x = pack2(o0[0], o0[1]); w0.y = pack2(o0[2], o0[3]); w1.x = pack2(o1[0], o1[1]); w1.y = pack2(o1[2], o1[3]);
                    *(uint2*)(QK + (size_t)row * 2304 + cb) = w0;
                    *(uint2*)(QK + (size_t)row * 2304 + cb + 16) = w1;
                } else {
                    const int c = cb - 2304;
#pragma unroll
                    for (int j = 0; j < 4; ++j) { VtC[(size_t)(c + j) * NTOK + row] = f2bf(v0[j]); VtC[(size_t)(c + 16 + j) * NTOK + row] = f2bf(v1[j]); }
                    if (!sample) { *(f32x4*)(ncv + (size_t)row * 256 + c) = v0; *(f32x4*)(ncv + (size_t)row * 256 + c + 16) = v1; }
                }
            }
        }
    }
};

template <int MODE>
DEV void attn_item(const Params& p, int item, char* smem) {
    constexpr int HD = (MODE <= 1) ? 128 : 64;
    constexpr int KST = HD + 8;
    constexpr int NKS = HD / 32, ND = HD / 16;
    constexpr int NH = (MODE <= 1) ? 1 : 2;
    constexpr int NR = (HD == 128) ? 4 : 2;
    constexpr int KCH = HD / 8;
    bf16_t* Ks = (bf16_t*)smem;
    bf16_t* Vt = Ks + 64 * KST;
    bf16_t* Ps = Vt + HD * 72;
    float* bias_s = (float*)(Ps + 4 * 16 * 72);
    const int tid = HTID, lane = tid & 63, w = tid >> 6, fr = lane & 15, fq = lane >> 4;
    const float scale = (MODE <= 1) ? 0.08838834764831845f : 0.125f;

    const bf16_t* PA = (const bf16_t*)(p.ws + R2_PA);
    const bf16_t* VtA = (const bf16_t*)(p.ws + R2_VTA);
    const bf16_t* QKC = (const bf16_t*)(p.ws + R2_QKC);
    const bf16_t* VtC = (const bf16_t*)(p.ws + R2_VTC);
    bf16_t* O = (bf16_t*)(p.ws + R3);

    int b, h, qt, qrow0, ntot, rs = 0, r = 0, kvh = 0, kt0 = 0, nloc = 0;
    const bf16_t* qptr; int qstride;
    bf16_t* optr;
    if (MODE == 0) {
        qt = item & 3; h = (item >> 2) & 7; b = item >> 5;
        qrow0 = b * 256 + qt * 64; qptr = PA + (size_t)qrow0 * 2048 + h * 128; qstride = 2048; ntot = 4;
        optr = O + (size_t)qrow0 * 2048 + h * 128;
    } else if (MODE == 1) {
        r = item & 63; h = (item >> 6) & 7; b = item >> 9; qt = r;
        qrow0 = NPR + b * 4096 + r * 64; qptr = PA + (size_t)qrow0 * 2048 + h * 128; qstride = 2048; ntot = 12; nloc = 8;
        rs = min(max(r - 4, 0), 56);
        optr = O + (size_t)qrow0 * 2048 + h * 128;
    } else if (MODE == 2) {
        qt = item & 3; const int hg = (item >> 2) & 15; b = item >> 6; h = hg * 2; kvh = hg >> 2;
        qrow0 = b * 256 + qt * 64; qptr = QKC + (size_t)qrow0 * 2304 + h * 64; qstride = 2304; ntot = 4;
        optr = O + (size_t)qrow0 * 2048 + h * 64;
    } else {
        qt = (item >> 1) & 63; const int hg = ((item >> 7) & 7) * 2 + (item & 1); b = item >> 10; h = hg * 2; kvh = hg >> 2;
        qrow0 = NPR + b * 4096 + qt * 64; qptr = QKC + (size_t)qrow0 * 2304 + h * 64; qstride = 2304;
        kt0 = max(qt - 2, 0); nloc = min(qt + 2, 63) - kt0 + 1; ntot = nloc + 4;
        optr = O + (size_t)qrow0 * 2048 + h * 64;
    }

    const bf16_t* kptr; const bf16_t* vptr; int kstride, vstride;
#define AT_PTRS(n) do { \
        if (MODE == 0) { const int krow0 = b * 256 + (n) * 64; \
            kptr = PA + (size_t)krow0 * 2048 + 1024 + h * 128; kstride = 2048; vptr = VtA + (size_t)(h * 128) * NTOK + krow0; vstride = NTOK; } \
        else if (MODE == 1) { \
            if ((n) < 8) { const int krow0 = NPR + b * 4096 + (rs + (n)) * 64; \
                kptr = PA + (size_t)krow0 * 2048 + 1024 + h * 128; kstride = 2048; vptr = VtA + (size_t)(h * 128) * NTOK + krow0; vstride = NTOK; } \
            else { const bf16_t* cKA = (const bf16_t*)(p.out + O_CK); const bf16_t* cVtA = cKA + (size_t)4 * 8 * 256 * 128; \
                kptr = cKA + ((size_t)(b * 8 + h) * 256 + ((n) - 8) * 64) * 128; kstride = 128; \
                vptr = cVtA + (size_t)(b * 8 + h) * 128 * 256 + ((n) - 8) * 64; vstride = 256; } } \
        else if (MODE == 2) { const int krow0 = b * 256 + (n) * 64; \
            kptr = QKC + (size_t)krow0 * 2304 + 2048 + kvh * 64; kstride = 2304; vptr = VtC + (size_t)(kvh * 64) * NTOK + krow0; vstride = NTOK; } \
        else { \
            if ((n) < nloc) { const int krow0 = NPR + b * 4096 + (kt0 + (n)) * 64; \
                kptr = QKC + (size_t)krow0 * 2304 + 2048 + kvh * 64; kstride = 2304; vptr = VtC + (size_t)(kvh * 64) * NTOK + krow0; vstride = NTOK; } \
            else { const bf16_t* cKC = (const bf16_t*)(p.ws + S_CKC); const bf16_t* cVtC = (const bf16_t*)(p.ws + S_CVTC); \
                kptr = cKC + ((size_t)(b * 4 + kvh) * 256 + ((n) - nloc) * 64) * 64; kstride = 64; \
                vptr = cVtC + (size_t)(b * 4 + kvh) * 64 * 256 + ((n) - nloc) * 64; vstride = 256; } } \
    } while (0)
    const int krow = tid / KCH, kch = tid % KCH;
    const int vrow = tid >> 3, vch = tid & 7;
    uint4 kr0, kr1, kr2, kr3, vr0, vr1, vr2, vr3;
    kr2 = kr3 = vr2 = vr3 = make_uint4(0, 0, 0, 0);
#define AT_LOAD(n) do { AT_PTRS(n); \
        kr0 = *(const uint4*)(kptr + (size_t)krow * kstride + kch * 8); kr1 = *(const uint4*)(kptr + (size_t)(krow + 256 / KCH) * kstride + kch * 8); \
        vr0 = *(const uint4*)(vptr + (size_t)vrow * vstride + vch * 8); vr1 = *(const uint4*)(vptr + (size_t)(vrow + 32) * vstride + vch * 8); \
        if (NR == 4) { kr2 = *(const uint4*)(kptr + (size_t)(krow + 2 * (256 / KCH)) * kstride + kch * 8); kr3 = *(const uint4*)(kptr + (size_t)(krow + 3 * (256 / KCH)) * kstride + kch * 8); \
                       vr2 = *(const uint4*)(vptr + (size_t)(vrow + 64) * vstride + vch * 8); vr3 = *(const uint4*)(vptr + (size_t)(vrow + 96) * vstride + vch * 8); } \
    } while (0)
#define AT_STORE() do { \
        *(uint4*)(Ks + krow * KST + kch * 8) = kr0; *(uint4*)(Ks + (krow + 256 / KCH) * KST + kch * 8) = kr1; \
        *(uint4*)(Vt + vrow * 72 + vch * 8) = vr0; *(uint4*)(Vt + (vrow + 32) * 72 + vch * 8) = vr1; \
        if (NR == 4) { *(uint4*)(Ks + (krow + 2 * (256 / KCH)) * KST + kch * 8) = kr2; *(uint4*)(Ks + (krow + 3 * (256 / KCH)) * KST + kch * 8) = kr3; \
                       *(uint4*)(Vt + (vrow + 64) * 72 + vch * 8) = vr2; *(uint4*)(Vt + (vrow + 96) * 72 + vch * 8) = vr3; } \
    } while (0)

    AT_LOAD(0);
    constexpr float LOG2E = 1.4426950408889634f;
    const float c1 = scale * LOG2E;
    bf16x8 qf[NH][NKS];
    float mrow[NH], lpart[NH];
    f32x4 oacc[NH][ND];
#pragma unroll
    for (int hh = 0; hh < NH; ++hh) {
#pragma unroll
        for (int ks = 0; ks < NKS; ++ks) qf[hh][ks] = *(const bf16x8*)(qptr + (size_t)(16 * w + fr) * qstride + hh * 64 + ks * 32 + fq * 8);
        mrow[hh] = (MODE >= 2) ? p.in[I_SINK][h + hh] * LOG2E : -1e30f;
        lpart[hh] = (MODE >= 2 && fq == 0) ? 1.f : 0.f;
#pragma unroll
        for (int nd = 0; nd < ND; ++nd) oacc[hh][nd] = (f32x4){0.f, 0.f, 0.f, 0.f};
    }
    BAR_LDS();
    if (MODE == 1) { for (int i = tid; i < 465; i += 256) bias_s[i] = p.in[I_RELB][h * 465 + i] * LOG2E; }
    const int qi = 16 * w + fr;

#pragma unroll 1
    for (int n = 0; n < ntot; ++n) {
        if (n) BAR_LDS();
        AT_STORE();
        BAR_LDS();
        { const int nn = min(n + 1, ntot - 1); AT_LOAD(nn); }
        const bool local = n < nloc;
        const int dkt = (MODE == 3) ? (kt0 + n - qt) : 0;
#pragma unroll
        for (int hh = 0; hh < NH; ++hh) {
            f32x4 sacc[4];
#pragma unroll
            for (int nb = 0; nb < 4; ++nb) sacc[nb] = (f32x4){0.f, 0.f, 0.f, 0.f};
#pragma unroll
            for (int ks = 0; ks < NKS; ++ks)
#pragma unroll
                for (int nb = 0; nb < 4; ++nb) {
                    const bf16x8 kf = *(const bf16x8*)(Ks + (nb * 16 + fr) * KST + ks * 32 + fq * 8);
                    sacc[nb] = mfma16(kf, qf[hh][ks], sacc[nb]);
                }
            if (MODE == 1 && local) {
                const int cs = min(max(qi - 8, 0), 48);
                const float* brow = bias_s + (rs + n - r + 7) * 31 + 15 - qi;
#pragma unroll
                for (int nb = 0; nb < 4; ++nb)
#pragma unroll
                    for (int j = 0; j < 4; ++j) {
                        const int kj = nb * 16 + 4 * fq + j;
                        const bool ok = kj >= cs && kj < cs + 16;
                        sacc[nb][j] = ok ? sacc[nb][j] * c1 + brow[ok ? kj : qi] : -1e30f;
                    }
            } else if (MODE == 3 && local && (dkt == 2 || dkt == -2)) {
#pragma unroll
                for (int nb = 0; nb < 4; ++nb)
#pragma unroll
                    for (int j = 0; j < 4; ++j) {
                        const int dlt = dkt * 64 + nb * 16 + 4 * fq + j - qi;
                        sacc[nb][j] = (dlt > 128 || dlt < -128) ? -1e30f : sacc[nb][j] * c1;
                    }
            } else {
#pragma unroll
                for (int nb = 0; nb < 4; ++nb)
#pragma unroll
                    for (int j = 0; j < 4; ++j) sacc[nb][j] *= c1;
            }
            float mx = sacc[0][0];
#pragma unroll
            for (int nb = 0; nb < 4; ++nb)
#pragma unroll
                for (int j = 0; j < 4; ++j) mx = fmaxf(mx, sacc[nb][j]);
            mx = fmaxf(mx, __shfl_xor(mx, 16));
            mx = fmaxf(mx, __shfl_xor(mx, 32));
            const float mnew = fmaxf(mrow[hh], mx);
            const float alpha = __builtin_amdgcn_exp2f(mrow[hh] - mnew);
            mrow[hh] = mnew;
            float psum = 0.f;
#pragma unroll
            for (int nb = 0; nb < 4; ++nb)
#pragma unroll
                for (int j = 0; j < 4; ++j) { const float pv = __builtin_amdgcn_exp2f(sacc[nb][j] - mnew); sacc[nb][j] = pv; psum += pv; }
            lpart[hh] = lpart[hh] * alpha + psum;
#pragma unroll
            for (int nd = 0; nd < ND; ++nd)
#pragma unroll
                for (int j = 0; j < 4; ++j) oacc[hh][nd][j] *= alpha;
#pragma unroll
            for (int ks = 0; ks < 2; ++ks) {
                union { u32 u[4]; bf16x8 v; } pf;
                pf.u[0] = pack2(sacc[2 * ks][0], sacc[2 * ks][1]); pf.u[1] = pack2(sacc[2 * ks][2], sacc[2 * ks][3]);
                pf.u[2] = pack2(sacc[2 * ks + 1][0], sacc[2 * ks + 1][1]); pf.u[3] = pack2(sacc[2 * ks + 1][2], sacc[2 * ks + 1][3]);
#pragma unroll
                for (int nd = 0; nd < ND; ++nd) {
                    union { uint2 h2[2]; bf16x8 v; } vf;
                    vf.h2[0] = *(const uint2*)(Vt + (nd * 16 + fr) * 72 + ks * 32 + 4 * fq);
                    vf.h2[1] = *(const uint2*)(Vt + (nd * 16 + fr) * 72 + ks * 32 + 16 + 4 * fq);
                    oacc[hh][nd] = mfma16(vf.v, pf.v, oacc[hh][nd]);
                }
            }
        }
    }
#pragma unroll
    for (int hh = 0; hh < NH; ++hh) {
        float l = lpart[hh];
        l += __shfl_xor(l, 16);
        l += __shfl_xor(l, 32);
        const float linv = 1.f / l;
#pragma unroll
        for (int nd = 0; nd < ND; ++nd) {
            uint2 o;
            o.x = pack2(oacc[hh][nd][0] * linv, oacc[hh][nd][1] * linv);
            o.y = pack2(oacc[hh][nd][2] * linv, oacc[hh][nd][3] * linv);
            *(uint2*)(optr + (size_t)(16 * w + fr) * 2048 + hh * 64 + nd * 16 + 4 * fq) = o;
        }
    }
#undef AT_PTRS
#undef AT_LOAD
#undef AT_STORE
}

DEV void dn_prep_item(const Params& p, int item, char* smem) {
    const int tid = HTID, lane = tid & 63, w = tid >> 6, fr = lane & 15, fq = lane >> 4;
    const int cidx = item >> 3, h = item & 7;
    const int row0 = cidx * 64;
    int seq_start, seq_end;
    if (row0 < NPR) { seq_start = row0 & ~255; seq_end = seq_start + 256; }
    else { seq_start = NPR + ((row0 - NPR) & ~4095); seq_end = seq_start + 4096; }
    bf16_t* qs = (bf16_t*)smem;
    bf16_t* ks = qs + 64 * 136;
    bf16_t* vs = ks + 64 * 136;
    float* Ms = (float*)smem;
    float* sm_beta = (float*)(smem + 3 * 17408);
    float* sm_gc = sm_beta + 128;
    float* sm_su = sm_gc + 128;
    float* sm_sw = sm_su + 128;
    const bf16_t* PB = (const bf16_t*)(p.ws + R2_PB);
    const float* gates = (const float*)(p.ws + S_GATES);
    bf16_t* QN = (bf16_t*)(p.ws + R1_QN);
    bf16_t* KNT = (bf16_t*)(p.ws + R1_KNT);
    bf16_t* UT = (bf16_t*)(p.out);
    bf16_t* Wb = UT + (size_t)6144 * 128 * 64;
    bf16_t* QKb = (bf16_t*)(p.ws + R2_QK);
    float* GC = (float*)(p.ws + S_GC);
    const float* conv = p.in[I_CONV];

    BAR_LDS();
    {
        const int i = tid >> 2, dq = tid & 3;
        const int row = row0 + i;
        const bool hasPrev = (row - 1) >= seq_start, hasNext = (row + 1) < seq_end;
        const int offPrev = hasPrev ? -3072 : 0, offNext = hasNext ? 3072 : 0;
        auto ldpart = [&](uint4 (&x)[3][4], int part) __attribute__((always_inline)) {
            const bf16_t* px = PB + (size_t)row * 3072 + part * 1024 + h * 128 + dq * 32;
#pragma unroll
            for (int c8 = 0; c8 < 4; ++c8) {
                x[1][c8] = *(const uint4*)(px + c8 * 8);
                x[0][c8] = *(const uint4*)(px + c8 * 8 + offPrev);
                x[2][c8] = *(const uint4*)(px + c8 * 8 + offNext);
            }
        };
        auto do_part = [&](const uint4 (&x)[3][4], int part) __attribute__((always_inline)) {
            const int colbase = part * 1024 + h * 128 + dq * 32;
            float y[32];
            float ss = 0.f;
#pragma unroll
            for (int c8 = 0; c8 < 4; ++c8) {
                const uint4 x1 = x[1][c8];
                const uint4 x0 = hasPrev ? x[0][c8] : make_uint4(0, 0, 0, 0), x2 = hasNext ? x[2][c8] : make_uint4(0, 0, 0, 0);
                const float* wq = conv + colbase + c8 * 8;
                const u32 a0[4] = {x0.x, x0.y, x0.z, x0.w}, a1[4] = {x1.x, x1.y, x1.z, x1.w}, a2[4] = {x2.x, x2.y, x2.z, x2.w};
#pragma unroll
                for (int e2 = 0; e2 < 4; ++e2) {
                    const float2 w0 = *(const float2*)(wq + 2 * e2), w1 = *(const float2*)(wq + 3072 + 2 * e2), w2 = *(const float2*)(wq + 6144 + 2 * e2);
                    const float va = w0.x * bflo(a0[e2]) + w1.x * bflo(a1[e2]) + w2.x * bflo(a2[e2]);
                    const float vb = w0.y * bfhi(a0[e2]) + w1.y * bfhi(a1[e2]) + w2.y * bfhi(a2[e2]);
                    const float ya = siluf(va), yb = siluf(vb);
                    y[c8 * 8 + 2 * e2] = ya; y[c8 * 8 + 2 * e2 + 1] = yb;
                    ss += ya * ya + yb * yb;
                }
            }
            float sc = 1.f;
            if (part < 2) {
                ss += __shfl_xor(ss, 1); ss += __shfl_xor(ss, 2);
                sc = rsqrtf(ss + 1e-6f) * (part == 0 ? 0.08838834764831845f : 1.f);
            }
            bf16_t* dst = (part == 0 ? qs : (part == 1 ? ks : vs)) + i * 136 + dq * 32;
#pragma unroll
            for (int c8 = 0; c8 < 4; ++c8) {
                uint4 o;
                o.x = pack2(y[c8 * 8 + 0] * sc, y[c8 * 8 + 1] * sc); o.y = pack2(y[c8 * 8 + 2] * sc, y[c8 * 8 + 3] * sc);
                o.z = pack2(y[c8 * 8 + 4] * sc, y[c8 * 8 + 5] * sc); o.w = pack2(y[c8 * 8 + 6] * sc, y[c8 * 8 + 7] * sc);
                *(uint4*)(dst + c8 * 8) = o;
                if (part == 0) *(uint4*)(QN + (size_t)row * 1024 + h * 128 + dq * 32 + c8 * 8) = o;
            }
        };
        uint4 xa[3][4], xb[3][4];
        ldpart(xa, 0);
        ldpart(xb, 1);
        do_part(xa, 0);
        ldpart(xa, 2);
        do_part(xb, 1);
        do_part(xa, 2);
    }
    if (tid < 128) {
        const int dir = tid >> 6, ii = tid & 63;
        const int rr = row0 + (dir ? 63 - ii : ii);
        const float braw = gates[(size_t)rr * 32 + dir * 8 + h], araw = gates[(size_t)rr * 32 + 16 + dir * 8 + h];
        const float beta = 1.f / (1.f + __expf(-braw));
        const float xx = araw + p.in[I_DTB][dir * 8 + h];
        const float sp = xx > 20.f ? xx : log1pf(__expf(xx));
        const float gval = -__expf(p.in[I_ALOG][dir * 8 + h]) * sp;
        float c = gval;
#pragma unroll
        for (int o = 1; o < 64; o <<= 1) { const float tt = __shfl_up(c, o); if (ii >= o) c += tt; }
        sm_beta[dir * 64 + ii] = beta; sm_gc[dir * 64 + ii] = c;
        sm_su[dir * 64 + ii] = beta; sm_sw[dir * 64 + ii] = beta * __expf(c);
        GC[((size_t)(cidx * 8 + h) * 2 + dir) * 64 + ii] = c;
    }
    BAR_LDS();
    {
#pragma unroll
        for (int i = 0; i < 4; ++i) {
            const int pc = tid + 256 * i, dk = pc >> 3, c8 = (pc & 7) * 8;
            const bf16_t* src = ks + c8 * 136 + dk;
            uint4 o;
            o.x = (u32)src[0] | ((u32)src[136] << 16); o.y = (u32)src[2 * 136] | ((u32)src[3 * 136] << 16);
            o.z = (u32)src[4 * 136] | ((u32)src[5 * 136] << 16); o.w = (u32)src[6 * 136] | ((u32)src[7 * 136] << 16);
            *(uint4*)(KNT + ((size_t)(cidx * 8 + h) * 128 + dk) * 64 + c8) = o;
        }
    }
    {
        f32x4 qk[4];
#pragma unroll
        for (int nb = 0; nb < 4; ++nb) qk[nb] = (f32x4){0.f, 0.f, 0.f, 0.f};
#pragma unroll
        for (int k4 = 0; k4 < 4; ++k4) {
            const bf16x8 aq = *(const bf16x8*)(qs + (16 * w + fr) * 136 + k4 * 32 + fq * 8);
#pragma unroll
            for (int nb = 0; nb < 4; ++nb) {
                const bf16x8 bk = *(const bf16x8*)(ks + (nb * 16 + fr) * 136 + k4 * 32 + fq * 8);
                qk[nb] = mfma16(aq, bk, qk[nb]);
            }
        }
#pragma unroll
        for (int dir = 0; dir < 2; ++dir) {
            const size_t ib = (size_t)(cidx * 8 + h) * 2 + dir;
#pragma unroll
            for (int nb = 0; nb < 4; ++nb)
#pragma unroll
                for (int j = 0; j < 4; ++j) {
                    const int io = 16 * w + 4 * fq + j, jo = nb * 16 + fr;
                    const int ip = dir ? 63 - io : io, jp = dir ? 63 - jo : jo;
                    const float dec = __expf(fminf(sm_gc[dir * 64 + ip] - sm_gc[dir * 64 + jp], 0.f));
                    QKb[(ib * 64 + ip) * 64 + jp] = f2bf((ip >= jp) ? qk[nb][j] * dec : 0.f);
                }
        }
    }
    BAR_LDS();
#pragma unroll 1
    for (int dir = 0; dir < 2; ++dir) {
        const size_t ib = (size_t)(cidx * 8 + h) * 2 + dir;
        {
            f32x4 kk[4];
#pragma unroll
            for (int nb = 0; nb < 4; ++nb) kk[nb] = (f32x4){0.f, 0.f, 0.f, 0.f};
#pragma unroll
            for (int k4 = 0; k4 < 4; ++k4) {
                const bf16x8 ak = *(const bf16x8*)(ks + (16 * w + fr) * 136 + k4 * 32 + fq * 8);
#pragma unroll
                for (int nb = 0; nb < 4; ++nb) {
                    const bf16x8 bk = *(const bf16x8*)(ks + (nb * 16 + fr) * 136 + k4 * 32 + fq * 8);
                    kk[nb] = mfma16(ak, bk, kk[nb]);
                }
            }
#pragma unroll
            for (int nb = 0; nb < 4; ++nb)
#pragma unroll
                for (int j = 0; j < 4; ++j) {
                    const int io = 16 * w + 4 * fq + j, jo = nb * 16 + fr;
                    const int ip = dir ? 63 - io : io, jp = dir ? 63 - jo : jo;
                    const float dec = __expf(fminf(sm_gc[dir * 64 + ip] - sm_gc[dir * 64 + jp], 0.f));
                    Ms[ip * 68 + jp] = (ip > jp) ? sm_beta[dir * 64 + ip] * kk[nb][j] * dec : 0.f;
                }
        }
        BAR_LDS();
        {
            const bool isU = tid < 128;
            const int col = tid & 127;
            const bf16_t* src = isU ? vs : ks;
            const float* scl = (isU ? sm_su : sm_sw) + dir * 64;
            float x[64];
            f32x4 mc[16], mn[16];
            float rc = bf2f(src[(dir ? 63 : 0) * 136 + col]) * scl[0], rn = 0.f;
#pragma unroll
            for (int i = 0; i < 64; ++i) {
                if (i + 1 < 64) {
                    const int pos = dir ? 62 - i : i + 1;
                    rn = bf2f(src[pos * 136 + col]) * scl[i + 1];
#pragma unroll
                    for (int q = 0; q < (i + 4) / 4; ++q) mn[q] = *(const f32x4*)(Ms + (i + 1) * 68 + 4 * q);
                }
                asm volatile("" ::: "memory");
                float a = rc;
#pragma unroll
                for (int j = 0; j < i; ++j) a -= mc[j >> 2][j & 3] * x[j];
                x[i] = a;
                rc = rn;
#pragma unroll
                for (int q = 0; q < (i + 4) / 4; ++q) mc[q] = mn[q];
            }
            BAR_LDS();
            bf16_t* XT = (bf16_t*)Ms;
            if (isU) {
#pragma unroll
                for (int g4 = 0; g4 < 16; ++g4) {
                    uint2 o; o.x = pack2(x[g4 * 4 + 0], x[g4 * 4 + 1]); o.y = pack2(x[g4 * 4 + 2], x[g4 * 4 + 3]);
                    *(uint2*)(XT + col * 68 + g4 * 4) = o;
                }
            } else {
                bf16_t* dst = Wb + (ib * 64) * 128 + col;
#pragma unroll
                for (int i = 0; i < 64; ++i) dst[i * 128] = f2bf(x[i]);
            }
            BAR_LDS();
            {
                bf16_t* dst = UT + (ib * 128) * 64;
#pragma unroll
                for (int i = 0; i < 4; ++i) {
                    const int pc = tid + 256 * i, rw = pc >> 3, c8 = (pc & 7) * 8;
                    const uint2 lo = *(const uint2*)(XT + rw * 68 + c8), hi = *(const uint2*)(XT + rw * 68 + c8 + 4);
                    *(uint4*)(dst + rw * 64 + c8) = make_uint4(lo.x, lo.y, hi.x, hi.y);
                }
            }
        }
        BAR_LDS();
    }
}

DEV void dn_scan_item(const Params& p, int chain, bool sample, char* smem) {
    const int tid = HTID, lane = tid & 63, w = tid >> 6, fr = lane & 15, fq = lane >> 4;
    const int slice = HALF_ID;
    const int dir = chain & 1, h = (chain >> 1) & 7, sq = chain >> 4;
    const int nch = sample ? 64 : 4;
    const int cbase = sample ? 128 + sq * 64 : sq * 4;
    bf16_t* Ss = (bf16_t*)smem;
    bf16_t* VNs = Ss + 64 * 136;
    bf16_t* VSs = VNs + 64 * 72;
    bf16_t* Os = VSs + 64 * 72;
    const bf16_t* QN = (const bf16_t*)(p.ws + R1_QN);
    const bf16_t* KNT = (const bf16_t*)(p.ws + R1_KNT);
    const bf16_t* UT = (const bf16_t*)(p.out);
    const bf16_t* Wb = UT + (size_t)6144 * 128 * 64;
    const bf16_t* QKb = (const bf16_t*)(p.ws + R2_QK);
    const float* GC = (const float*)(p.ws + S_GC);
    bf16_t* OB = (bf16_t*)(p.ws + R2_PB);

    f32x4 sacc[2][4];
#pragma unroll
    for (int rt = 0; rt < 2; ++rt)
#pragma unroll
        for (int ct = 0; ct < 4; ++ct) {
            if (sample) {
                const float* src = p.in[dir ? I_SBB : I_SBF] + (size_t)(sq * 8 + h) * 128 * 128;
#pragma unroll
                for (int j = 0; j < 4; ++j) sacc[rt][ct][j] = src[(size_t)(32 * w + 16 * rt + 4 * fq + j) * 128 + slice * 64 + 16 * ct + fr];
            } else sacc[rt][ct] = (f32x4){0.f, 0.f, 0.f, 0.f};
        }
    BAR_LDS();
#pragma unroll
    for (int rt = 0; rt < 2; ++rt)
#pragma unroll
        for (int ct = 0; ct < 4; ++ct) {
            uint2 o; o.x = pack2(sacc[rt][ct][0], sacc[rt][ct][1]); o.y = pack2(sacc[rt][ct][2], sacc[rt][ct][3]);
            *(uint2*)(Ss + (16 * ct + fr) * 136 + 32 * w + 16 * rt + 4 * fq) = o;
        }
    const int ipA = 16 * w + fr;
    const int posA = dir ? 63 - ipA : ipA;
    const int i0 = 16 * w + 4 * fq;
    struct ScanOps { bf16x8 wf[4], qf[4]; uint2 uf[4]; float4 gc4; float glast; int row0; };
    auto scan_load = [&](ScanOps& o, int s) __attribute__((always_inline)) {
        const int cs = dir ? nch - 1 - s : s;
        const int cidx = cbase + cs, row0 = cidx * 64;
        const size_t ib = (size_t)(cidx * 8 + h) * 2 + dir;
        o.row0 = row0;
#pragma unroll
        for (int k4 = 0; k4 < 4; ++k4) {
            o.wf[k4] = *(const bf16x8*)(Wb + (ib * 64 + ipA) * 128 + k4 * 32 + fq * 8);
            o.qf[k4] = *(const bf16x8*)(QN + (size_t)(row0 + posA) * 1024 + h * 128 + k4 * 32 + fq * 8);
        }
#pragma unroll
        for (int ct = 0; ct < 4; ++ct) o.uf[ct] = *(const uint2*)(UT + (ib * 128 + slice * 64 + 16 * ct + fr) * 64 + i0);
        o.gc4 = *(const float4*)(GC + ib * 64 + i0);
        o.glast = GC[ib * 64 + 63];
    };
    int orow_prev = 0;
    ScanOps nxt;
    scan_load(nxt, 0);
#pragma unroll 1
    for (int s = 0; s < nch; ++s) {
        const ScanOps cur = nxt;
        scan_load(nxt, min(s + 1, nch - 1));
        const int row0 = cur.row0;
        bf16x8 qkf[2], knf[2][2];
        {
            const int cidx = row0 >> 6;
            const size_t ib = (size_t)(cidx * 8 + h) * 2 + dir;
#pragma unroll
            for (int k2 = 0; k2 < 2; ++k2) {
                qkf[k2] = *(const bf16x8*)(QKb + (ib * 64 + ipA) * 64 + k2 * 32 + fq * 8);
#pragma unroll
                for (int rt = 0; rt < 2; ++rt)
                    knf[rt][k2] = *(const bf16x8*)(KNT + ((size_t)(cidx * 8 + h) * 128 + 32 * w + 16 * rt + fr) * 64 + k2 * 32 + fq * 8);
            }
        }
        const float glast = cur.glast;
        const float gcv[4] = {cur.gc4.x, cur.gc4.y, cur.gc4.z, cur.gc4.w};
#define wf cur.wf
#define qf cur.qf
#define uf cur.uf
        BAR_LDS();
        if (s > 0) {
#pragma unroll
            for (int i = 0; i < 2; ++i) {
                const int pc = tid + 256 * i, tk = pc >> 3, c8 = (pc & 7) * 8;
                *(uint4*)(OB + ((size_t)dir * NTOK + orow_prev + tk) * 1024 + h * 128 + slice * 64 + c8) = *(const uint4*)(Os + tk * 72 + c8);
            }
        }
        f32x4 wsv[4], qsv[4];
#pragma unroll
        for (int ct = 0; ct < 4; ++ct) { wsv[ct] = (f32x4){0.f, 0.f, 0.f, 0.f}; qsv[ct] = (f32x4){0.f, 0.f, 0.f, 0.f}; }
#pragma unroll
        for (int k4 = 0; k4 < 4; ++k4) {
            bf16x8 sf[4];
#pragma unroll
            for (int ct = 0; ct < 4; ++ct) sf[ct] = *(const bf16x8*)(Ss + (16 * ct + fr) * 136 + k4 * 32 + fq * 8);
            asm volatile("" ::: "memory");
#pragma unroll
            for (int ct = 0; ct < 4; ++ct) {
                wsv[ct] = mfma16(wf[k4], sf[ct], wsv[ct]);
                qsv[ct] = mfma16(qf[k4], sf[ct], qsv[ct]);
            }
        }
        float ek[4], eg[4];
#pragma unroll
        for (int j = 0; j < 4; ++j) { ek[j] = __expf(glast - gcv[j]); eg[j] = __expf(gcv[j]); }
#pragma unroll
        for (int ct = 0; ct < 4; ++ct) {
            float vn[4];
            vn[0] = bflo(uf[ct].x) - wsv[ct][0]; vn[1] = bfhi(uf[ct].x) - wsv[ct][1];
            vn[2] = bflo(uf[ct].y) - wsv[ct][2]; vn[3] = bfhi(uf[ct].y) - wsv[ct][3];
            uint2 o; o.x = pack2(vn[0], vn[1]); o.y = pack2(vn[2], vn[3]);
            *(uint2*)(VNs + (16 * ct + fr) * 72 + i0) = o;
            uint2 o2;
            if (dir == 0) { o2.x = pack2(vn[0] * ek[0], vn[1] * ek[1]); o2.y = pack2(vn[2] * ek[2], vn[3] * ek[3]);
                *(uint2*)(VSs + (16 * ct + fr) * 72 + i0) = o2; }
            else { o2.x = pack2(vn[3] * ek[3], vn[2] * ek[2]); o2.y = pack2(vn[1] * ek[1], vn[0] * ek[0]);
                *(uint2*)(VSs + (16 * ct + fr) * 72 + 60 - i0) = o2; }
        }
        BAR_LDS();
        bf16x8 vnf[4][2], vsf[4][2];
#pragma unroll
        for (int ct = 0; ct < 4; ++ct)
#pragma unroll
            for (int k2 = 0; k2 < 2; ++k2) vnf[ct][k2] = *(const bf16x8*)(VNs + (16 * ct + fr) * 72 + k2 * 32 + fq * 8);
#pragma unroll
        for (int ct = 0; ct < 4; ++ct)
#pragma unroll
            for (int k2 = 0; k2 < 2; ++k2) vsf[ct][k2] = *(const bf16x8*)(VSs + (16 * ct + fr) * 72 + k2 * 32 + fq * 8);
        asm volatile("" ::: "memory");
#pragma unroll
        for (int ct = 0; ct < 4; ++ct) {
            f32x4 oa;
#pragma unroll
            for (int j = 0; j < 4; ++j) oa[j] = qsv[ct][j] * eg[j];
#pragma unroll
            for (int k2 = 0; k2 < 2; ++k2) oa = mfma16(qkf[k2], vnf[ct][k2], oa);
#pragma unroll
            for (int j = 0; j < 4; ++j) {
                const int ip = i0 + j, pos = dir ? 63 - ip : ip;
                Os[pos * 72 + 16 * ct + fr] = f2bf(oa[j]);
            }
        }
        orow_prev = row0;
        const float cd = __expf(glast);
#pragma unroll
        for (int rt = 0; rt < 2; ++rt)
#pragma unroll
            for (int ct = 0; ct < 4; ++ct) {
#pragma unroll
                for (int j = 0; j < 4; ++j) sacc[rt][ct][j] *= cd;
#pragma unroll
                for (int k2 = 0; k2 < 2; ++k2) sacc[rt][ct] = mfma16(knf[rt][k2], vsf[ct][k2], sacc[rt][ct]);
                uint2 o; o.x = pack2(sacc[rt][ct][0], sacc[rt][ct][1]); o.y = pack2(sacc[rt][ct][2], sacc[rt][ct][3]);
                *(uint2*)(Ss + (16 * ct + fr) * 136 + 32 * w + 16 * rt + 4 * fq) = o;
            }
    }
#undef wf
#undef qf
#undef uf
    BAR_LDS();
#pragma unroll
    for (int i = 0; i < 2; ++i) {
        const int pc = tid + 256 * i, tk = pc >> 3, c8 = (pc & 7) * 8;
        *(uint4*)(OB + ((size_t)dir * NTOK + orow_prev + tk) * 1024 + h * 128 + slice * 64 + c8) = *(const uint4*)(Os + tk * 72 + c8);
    }
    if (!sample) {
        float* dst = p.out + (dir ? O_BB : O_BF) + (size_t)(sq * 8 + h) * 128 * 128;
#pragma unroll
        for (int rt = 0; rt < 2; ++rt)
#pragma unroll
            for (int ct = 0; ct < 4; ++ct)
#pragma unroll
                for (int j = 0; j < 4; ++j) dst[(size_t)(32 * w + 16 * rt + 4 * fq + j) * 128 + slice * 64 + 16 * ct + fr] = sacc[rt][ct][j];
    }
}

DEV void dn_final_phase(const Params& p) {
    const int lane = threadIdx.x & 63, wave = threadIdx.x >> 6;
    const bf16_t* OB = (const bf16_t*)(p.ws + R2_PB);
    const bf16_t* PZ = (const bf16_t*)(p.ws + R2_PZ);
    bf16_t* O = (bf16_t*)(p.ws + R3);
    const float* gn = p.in[I_ONORM];
    for (int row = blockIdx.x * 8 + wave; row < NTOK; row += gridDim.x * 8) {
        const int c0 = lane * 16;
        float v[16];
        float ss = 0.f;
#pragma unroll
        for (int hh = 0; hh < 2; ++hh) {
            const uint4 a = *(const uint4*)(OB + (size_t)row * 1024 + c0 + hh * 8);
            const uint4 b = *(const uint4*)(OB + ((size_t)NTOK + row) * 1024 + c0 + hh * 8);
            const u32 aa[4] = {a.x, a.y, a.z, a.w}, bb[4] = {b.x, b.y, b.z, b.w};
#pragma unroll
            for (int e = 0; e < 4; ++e) {
                const float lo = bflo(aa[e]) + bflo(bb[e]), hi = bfhi(aa[e]) + bfhi(bb[e]);
                v[hh * 8 + 2 * e] = lo; v[hh * 8 + 2 * e + 1] = hi;
                ss += lo * lo + hi * hi;
            }
        }
        ss += __shfl_xor(ss, 1); ss += __shfl_xor(ss, 2); ss += __shfl_xor(ss, 4);
        const float rstd = rsqrtf(ss * (1.f / 128.f) + 1e-6f);
#pragma unroll
        for (int hh = 0; hh < 2; ++hh) {
            const uint4 z = *(const uint4*)(PZ + (size_t)row * 1024 + c0 + hh * 8);
            const u32 zz[4] = {z.x, z.y, z.z, z.w};
            u32 o[4];
#pragma unroll
            for (int e = 0; e < 4; ++e) {
                const int d = (c0 + hh * 8 + 2 * e) & 127;
                const float lo = v[hh * 8 + 2 * e] * rstd * gn[d] * siluf(bflo(zz[e]));
                const float hi = v[hh * 8 + 2 * e + 1] * rstd * gn[d + 1] * siluf(bfhi(zz[e]));
                o[e] = pack2(lo, hi);
            }
            *(uint4*)(O + (size_t)row * 2048 + 1024 + c0 + hh * 8) = make_uint4(o[0], o[1], o[2], o[3]);
        }
    }
}

__global__ void __launch_bounds__(512) mega(Params p) {
    cg::grid_group grid = cg::this_grid();
    extern __shared__ __attribute__((aligned(16))) unsigned char dyn_lds[];
    LAS unsigned char* glds = (LAS unsigned char*)dyn_lds;
#define smem ((char*)dyn_lds + HALF_ID * HSMEM)
    int* s_item = (int*)((char*)dyn_lds + STAGE_LDS);
    float* ada = (float*)(p.ws + S_ADA);
    bf16_t* Xb = (bf16_t*)p.out;
    bf16_t* Xlast = (bf16_t*)(p.ws + R3);
    int ph = 0;
    unsigned* gbar = (unsigned*)(p.ws + S_BAR);
    const unsigned my_xcc = xcc_id();
    if (threadIdx.x == 0) __hip_atomic_fetch_add(gbar + 64 * my_xcc, 1u, __ATOMIC_RELAXED, __HIP_MEMORY_SCOPE_AGENT);
    unsigned n_here = 0, n_xcc = 0;
#define SYNC_OR_STOP() do { if (++ph > PHASE_STOP) return; \
        if (ph == 1) { grid.sync(); n_here = __hip_atomic_load(gbar + 64 * my_xcc, __ATOMIC_RELAXED, __HIP_MEMORY_SCOPE_AGENT); \
            _Pragma("unroll") for (int j = 0; j < 8; ++j) n_xcc += __hip_atomic_load(gbar + 64 * j, __ATOMIC_RELAXED, __HIP_MEMORY_SCOPE_AGENT) != 0u; } \
        else grid_barrier(gbar, (unsigned)(ph - 1), n_here, n_xcc, my_xcc); } while (0)

    phase0(p, smem);
    SYNC_OR_STOP();
    modulate_phase<false>(p.in[I_XP], p.in[I_XS], nullptr, p.in[I_NMIX], ada, 0, (bf16_t*)(p.ws + R1));
    SYNC_OR_STOP();
    {
        EpiProj0 e{(bf16_t*)(p.ws + R2_PA), (bf16_t*)(p.ws + R2_VTA), (bf16_t*)(p.ws + R2_PB), (bf16_t*)(p.ws + R2_PZ),
                   (float*)(p.ws + S_GATES), p.out + O_AK, p.out + O_AV};
        g8::gemm_phase(glds, (const bf16_t*)(p.ws + R1), (const bf16_t*)(p.ws + W_ABIN), NTOK, ABNP, DM, e);
    }
    SYNC_OR_STOP();
    for (int it = blockIdx.x * 2 + HALF_ID; it < 3072; it += gridDim.x * 2) dn_prep_item(p, it, smem);
    SYNC_OR_STOP();
    {
        int* ctr0 = (int*)(p.ws + S_CTR);
        int steal = 0;
        for (;;) {
            const int xcd = (int)((my_xcc + (unsigned)steal) & 7u);
            BAR_LDS();
            if (threadIdx.x == 0) *s_item = atomicAdd(ctr0 + xcd * 16, 1);
            BAR_LDS();
            const int q = *s_item;
            if (q >= 264) { if (++steal >= 8) break; continue; }
            if (q < 8) dn_scan_item(p, xcd * 8 + q, true, smem);
            else if (q < 72) dn_scan_item(p, xcd * 64 + (q - 8), false, smem);
            else if (q < 200) attn_item<1>(p, (xcd * 128 + (q - 72)) * 2 + HALF_ID, smem);
            else attn_item<0>(p, (xcd * 64 + (q - 200)) * 2 + HALF_ID, smem);
        }
    }
    SYNC_OR_STOP();
    dn_final_phase(p);
    SYNC_OR_STOP();
    {
        EpiRes<true> e{p.in[I_XP], p.in[I_XS], nullptr, Xb, ada + 2 * 2048};
        g8::gemm_phase(glds, (const bf16_t*)(p.ws + R3), (const bf16_t*)(p.ws + W_ABOUT), NTOK, DM, DM, e);
    }
    SYNC_OR_STOP();
    modulate_phase<true>(nullptr, nullptr, Xb, p.in[I_NMLP], ada, 3, (bf16_t*)(p.ws + R1));
    SYNC_OR_STOP();
    {
        EpiMlp1 e{(bf16_t*)(p.ws + R2)};
        g8::gemm_phase(glds, (const bf16_t*)(p.ws + R1), (const bf16_t*)(p.ws + W_MLPIN), NTOK, DFF, DM, e);
    }
    SYNC_OR_STOP();
    {
        EpiRes<false> e{nullptr, nullptr, Xb, Xb, ada + 5 * 2048};
        g8::gemm_phase(glds, (const bf16_t*)(p.ws + R2), (const bf16_t*)(p.ws + W_MLPOUT), NTOK, DM, DFF, e);
    }
    SYNC_OR_STOP();
    const float* ada1 = ada + 5 * 12288;
    modulate_phase<true>(nullptr, nullptr, Xb, p.in[I_NMIX] + DM, ada1, 0, (bf16_t*)(p.ws + R1));
    SYNC_OR_STOP();
    {
        EpiQkv1 e{(bf16_t*)(p.ws + R2_QKC), (bf16_t*)(p.ws + R2_VTC), p.out + O_CK, p.out + O_CV};
        g8::gemm_phase(glds, (const bf16_t*)(p.ws + R1), (const bf16_t*)(p.ws + W_CQKV), NTOK, 2560, DM, e);
    }
    SYNC_OR_STOP();
    {
        const int vb = (blockIdx.x & 7) * (gridDim.x >> 3) + (blockIdx.x >> 3);
        for (int it = vb * 2 + HALF_ID; it < 4096 + 2048; it += gridDim.x * 2) {
            if (it < 4096) attn_item<3>(p, it, smem); else attn_item<2>(p, it - 4096, smem);
        }
    }
    SYNC_OR_STOP();
    {
        EpiRes<false> e{nullptr, nullptr, Xb, Xb, ada1 + 2 * 2048};
        g8::gemm_phase(glds, (const bf16_t*)(p.ws + R3), (const bf16_t*)(p.ws + W_COUT), NTOK, DM, DM, e);
    }
    SYNC_OR_STOP();
    modulate_phase<true>(nullptr, nullptr, Xb, p.in[I_NMLP] + DM, ada1, 3, (bf16_t*)(p.ws + R1));
    SYNC_OR_STOP();
    {
        EpiMlp1 e{(bf16_t*)(p.ws + R2)};
        g8::gemm_phase(glds, (const bf16_t*)(p.ws + R1), (const bf16_t*)(p.ws + W_MLPIN + SZ_MLP), NTOK, DFF, DM, e);
    }
    SYNC_OR_STOP();
    {
        EpiRes<false> e{nullptr, nullptr, Xb, Xlast, ada1 + 5 * 2048};
        g8::gemm_phase(glds, (const bf16_t*)(p.ws + R2), (const bf16_t*)(p.ws + W_MLPOUT + SZ_MLP), NTOK, DM, DFF, e);
    }
    SYNC_OR_STOP();
    final_norm_phase(Xlast, p.out, p.in[I_FNORM]);
}

extern "C" void kernel_launch(void* const* d_in, const int* in_sizes, int n_in, void* d_out, int out_size, void* d_ws, size_t ws_size,
                              hipStream_t stream) {
    static int grid_blocks = 0;
    if (grid_blocks == 0) {
        int dev = 0, cus = 0, per_cu = 0;
        (void)hipGetDevice(&dev);
        (void)hipDeviceGetAttribute(&cus, hipDeviceAttributeMultiprocessorCount, dev);
        hipError_t ea = hipFuncSetAttribute((const void*)mega, hipFuncAttributeMaxDynamicSharedMemorySize, DYN_LDS);
        (void)hipOccupancyMaxActiveBlocksPerMultiprocessor(&per_cu, (const void*)mega, 512, DYN_LDS);
        if (per_cu < 1) fprintf(stderr, "kernel_launch: occupancy query says %d blocks/CU\n", per_cu);
        grid_blocks = cus;
        if (ea != hipSuccess || n_in != 27 || ws_size < WS_TOTAL || (cus & 7) != 0) {
            fprintf(stderr, "kernel_launch: need 27 inputs and %zu bytes of workspace, got %d / %zu (attr %d, cus %d)\n", (size_t)WS_TOTAL, n_in, ws_size, (int)ea, cus);
            grid_blocks = -1;
        }
    }
    if (grid_blocks < 0) return;
    Params p;
    memset(&p, 0, sizeof(p));
    for (int i = 0; i < 27; ++i) p.in[i] = (const float*)d_in[i];
    p.out = (float*)d_out;
    p.ws = (char*)d_ws;
    (void)hipMemsetAsync((char*)d_ws + S_ADA, 0, 2 * 5 * 12288 * 4 + 8192, stream);
    void* args[] = {&p};
    hipError_t e = hipLaunchCooperativeKernel((const void*)mega, dim3(grid_blocks), dim3(512), args, DYN_LDS, stream);
    if (e != hipSuccess) fprintf(stderr, "cooperative launch failed: %s (grid %d)\n", hipGetErrorString(e), grid_blocks);
}
```

```cpp
#include <hip/hip_runtime.h>
#include <hip/hip_cooperative_groups.h>
#include <cstdio>
#include <cstring>
namespace cg = cooperative_groups;

typedef unsigned short bf16_t;
typedef short bf16x8 __attribute__((ext_vector_type(8)));
typedef float f32x4 __attribute__((ext_vector_type(4)));
typedef unsigned int u32;

#define DEV __device__ __forceinline__
#define BAR_LDS() asm volatile("s_waitcnt lgkmcnt(0)\n\ts_barrier" ::: "memory")
#ifndef PHASE_STOP
#define PHASE_STOP 99
#endif

constexpr int NT = 256;
constexpr int DM = 2048;
constexpr int NTOK = 24576;
constexpr int NPR = 8192;
constexpr int DFF = 8192;
constexpr int ABN = 7200, ABNP = 7424;
constexpr int HSMEM = 56 * 1024;
constexpr int STAGE_LDS = 131072;
constexpr int DYN_LDS = STAGE_LDS + 64;
DEV int opaque_htid() { int t = (int)(threadIdx.x & 255); asm volatile("" : "+v"(t)); return t; }
#define HTID (opaque_htid())
#define HALF_ID (__builtin_amdgcn_readfirstlane((int)(threadIdx.x >> 8)))

enum { I_XP = 0, I_XS, I_CAK, I_CAV, I_SBF, I_SBB, I_CCK, I_CCV, I_C, I_CCTX, I_WADA, I_BADA, I_NMIX, I_NMLP,
       I_WMI, I_WMO, I_ABWI, I_ABWO, I_RELB, I_CONV, I_ALOG, I_DTB, I_ONORM, I_CWQKV, I_CWO, I_SINK, I_FNORM };

constexpr size_t O_YP = 0, O_YS = 16777216, O_AK = 50331648, O_AV = 58720256, O_BF = 67108864, O_BB = 71303168,
                 O_CK = 75497472, O_CV = 77594624;

constexpr size_t SZ_ABIN = (size_t)ABNP * DM * 2, SZ_SQ = (size_t)DM * DM * 2, SZ_CQKV = (size_t)2560 * DM * 2,
                 SZ_MLP = (size_t)DFF * DM * 2;
constexpr size_t W_ABIN = 0;
constexpr size_t W_ABOUT = W_ABIN + SZ_ABIN;
constexpr size_t W_CQKV = W_ABOUT + SZ_SQ;
constexpr size_t W_COUT = W_CQKV + SZ_CQKV;
constexpr size_t W_MLPIN = W_COUT + SZ_SQ;
constexpr size_t W_MLPOUT = W_MLPIN + 2 * SZ_MLP;
constexpr size_t R1 = W_MLPOUT + 2 * SZ_MLP;
constexpr size_t SZ_R1 = (size_t)NTOK * DM * 2;
constexpr size_t R2 = R1 + SZ_R1;
constexpr size_t SZ_R2 = (size_t)NTOK * DFF * 2;
constexpr size_t R3 = R2 + SZ_R2;
constexpr size_t SM0 = R3 + SZ_R1;
constexpr size_t S_ADA = SM0;
constexpr size_t S_BAR = S_ADA + 2 * 5 * 12288 * 4;
constexpr size_t S_GATES = S_BAR + 8192;
constexpr size_t S_GC = S_GATES + (size_t)NTOK * 32 * 4;
constexpr size_t S_CKC = S_GC + (size_t)6144 * 64 * 4;
constexpr size_t S_CVTC = S_CKC + (size_t)4 * 4 * 256 * 64 * 2;
constexpr size_t S_CTR = S_CVTC + (size_t)4 * 4 * 256 * 64 * 2;
constexpr size_t WS_TOTAL = S_CTR + 1024;
constexpr size_t R2_PA = R2;
constexpr size_t R2_VTA = R2_PA + (size_t)NTOK * 2048 * 2;
constexpr size_t R2_PB = R2_VTA + (size_t)1024 * NTOK * 2;
constexpr size_t R2_PZ = R2_PB + (size_t)NTOK * 3072 * 2;
constexpr size_t R2_QK = R2_PZ + (size_t)NTOK * 1024 * 2;
constexpr size_t R2_QKC = R2;
constexpr size_t R2_VTC = R2_QKC + (size_t)NTOK * 2304 * 2;
constexpr size_t R1_QN = R1;
constexpr size_t R1_KNT = R1 + (size_t)NTOK * 1024 * 2;

struct Params { const float* in[27]; float* out; char* ws; };

DEV unsigned xcc_id() { return (unsigned)__builtin_amdgcn_s_getreg((3 << 11) | 20) & 7u; }
DEV void grid_barrier(unsigned* bar, unsigned k, unsigned n_here, unsigned n_xcc, unsigned xcc) {
    asm volatile("s_waitcnt vmcnt(0)" ::: "memory");
    __syncthreads();
    if (threadIdx.x < 64) {
        if (threadIdx.x == 0) {
            const unsigned old = __hip_atomic_fetch_add(bar + 64 * (8 + xcc), 1u, __ATOMIC_RELAXED, __HIP_MEMORY_SCOPE_AGENT);
            if (old + 1u == k * n_here) {
                __builtin_amdgcn_fence(__ATOMIC_RELEASE, "agent");
                asm volatile("s_waitcnt vmcnt(0)" ::: "memory");
                __hip_atomic_fetch_add(bar + 64 * 16, 1u, __ATOMIC_RELAXED, __HIP_MEMORY_SCOPE_AGENT);
            }
            unsigned spins = 0;
            while (__hip_atomic_load(bar + 64 * 16, __ATOMIC_RELAXED, __HIP_MEMORY_SCOPE_AGENT) < k * n_xcc && ++spins < (1u << 24)) __builtin_amdgcn_s_sleep(1);
        }
        __builtin_amdgcn_fence(__ATOMIC_ACQUIRE, "agent");
        asm volatile("s_waitcnt vmcnt(0)" ::: "memory");
    }
    __syncthreads();
}
DEV bf16_t f2bf(float f) { u32 u = __float_as_uint(f); u += 0x7fffu + ((u >> 16) & 1u); return (bf16_t)(u >> 16); }
DEV float bf2f(bf16_t h) { return __uint_as_float(((u32)h) << 16); }
typedef __bf16 bf16x2n __attribute__((ext_vector_type(2)));
DEV u32 pack2(float a, float b) { bf16x2n v; v[0] = (__bf16)a; v[1] = (__bf16)b; return __builtin_bit_cast(u32, v); }
DEV float bflo(u32 w) { return __uint_as_float(w << 16); }
DEV float bfhi(u32 w) { return __uint_as_float(w & 0xffff0000u); }
DEV f32x4 mfma16(bf16x8 a, bf16x8 b, f32x4 c) { return __builtin_amdgcn_mfma_f32_16x16x32_bf16(a, b, c, 0, 0, 0); }
DEV float siluf(float v) { return v / (1.f + __expf(-v)); }
DEV int cond_of(int row) { return row < NPR ? 0 : 1 + ((row - NPR) >> 12); }

DEV void ada_item(const Params& p, int item, char* smem) {
    const int tid = HTID;
    const int kq = item & 3, cb = (item >> 2) % 96, l = (item >> 2) / 96, n0 = cb * 128, kbase = kq * 512;
    float* sc = (float*)smem;
    BAR_LDS();
    for (int idx = tid; idx < 5 * 512; idx += NT) {
        const int ci = idx >> 9, k = kbase + (idx & 511);
        const float v = ci == 0 ? p.in[I_CCTX][k] : p.in[I_C][(ci - 1) * 2048 + k];
        sc[idx] = siluf(v);
    }
    BAR_LDS();
    const int cg4 = tid & 31, kg = tid >> 5;
    float acc[5][4];
#pragma unroll
    for (int ci = 0; ci < 5; ++ci) { acc[ci][0] = acc[ci][1] = acc[ci][2] = acc[ci][3] = 0.f; }
    const float* wp = p.in[I_WADA] + (size_t)l * 2048 * 12288 + (size_t)kbase * 12288 + n0 + 4 * cg4;
#pragma unroll 8
    for (int k = kg; k < 512; k += 8) {
        const float4 w = *(const float4*)(wp + (size_t)k * 12288);
#pragma unroll
        for (int ci = 0; ci < 5; ++ci) {
            const float sv = sc[ci * 512 + k];
            acc[ci][0] += sv * w.x; acc[ci][1] += sv * w.y; acc[ci][2] += sv * w.z; acc[ci][3] += sv * w.w;
        }
    }
    BAR_LDS();
    float* red = (float*)smem;
#pragma unroll
    for (int ci = 0; ci < 5; ++ci)
#pragma unroll
        for (int e = 0; e < 4; ++e) red[(kg * 5 + ci) * 128 + 4 * cg4 + e] = acc[ci][e];
    BAR_LDS();
    float* ada = (float*)(p.ws + S_ADA);
    for (int idx = tid; idx < 640; idx += NT) {
        const int ci = idx >> 7, c = idx & 127;
        float sum = (kq == 0) ? p.in[I_BADA][l * 12288 + n0 + c] : 0.f;
#pragma unroll
        for (int g = 0; g < 8; ++g) sum += red[(g * 5 + ci) * 128 + c];
        atomicAdd(ada + (size_t)(l * 5 + ci) * 12288 + n0 + c, sum);
    }
}

DEV void phase0(const Params& p, char* smem) {
    if (blockIdx.x == 0 && threadIdx.x < 128) ((int*)(p.ws + S_CTR))[threadIdx.x] = 0;
    for (int it = blockIdx.x * 2 + HALF_ID; it < 768; it += gridDim.x * 2) ada_item(p, it, smem);
    constexpr int T_ABIN = 16 * 116, T_SQ = 16 * 32, T_CQKV = 16 * 40, T_MLPIN = 16 * 128, T_MLPOUT = 64 * 32;
    constexpr int E1 = T_ABIN, E2 = E1 + T_SQ, E3 = E2 + T_CQKV, E4 = E3 + T_SQ, E5 = E4 + 2 * T_MLPIN, E6 = E5 + 2 * T_MLPOUT;
    static_assert((E6 & 1) == 0, "even tile count: both halves of a block run the same number of barriers");
    const int tid = HTID;
    float* T = (float*)smem;
    const float* src; bf16_t* dst; int K, N, kt, ntl;
#define TR_DECODE(t_) do { int t = (t_); \
        if (t < E1) { src = p.in[I_ABWI]; dst = (bf16_t*)(p.ws + W_ABIN); K = 2048; N = ABN; ntl = t % 116; kt = t / 116; } \
        else if (t < E2) { t -= E1; src = p.in[I_ABWO]; dst = (bf16_t*)(p.ws + W_ABOUT); K = 2048; N = 2048; ntl = t % 32; kt = t / 32; } \
        else if (t < E3) { t -= E2; src = p.in[I_CWQKV]; dst = (bf16_t*)(p.ws + W_CQKV); K = 2048; N = 2560; ntl = t % 40; kt = t / 40; } \
        else if (t < E4) { t -= E3; src = p.in[I_CWO]; dst = (bf16_t*)(p.ws + W_COUT); K = 2048; N = 2048; ntl = t % 32; kt = t / 32; } \
        else if (t < E5) { t -= E4; const int l = t / T_MLPIN; t -= l * T_MLPIN; src = p.in[I_WMI] + (size_t)l * 2048 * 8192; \
            dst = (bf16_t*)(p.ws + W_MLPIN + (size_t)l * SZ_MLP); K = 2048; N = 8192; ntl = t % 128; kt = t / 128; } \
        else { t -= E5; const int l = t / T_MLPOUT; t -= l * T_MLPOUT; src = p.in[I_WMO] + (size_t)l * 8192 * 2048; \
            dst = (bf16_t*)(p.ws + W_MLPOUT + (size_t)l * SZ_MLP); K = 8192; N = 2048; ntl = t % 32; kt = t / 32; } } while (0)
    float4 A0, A1, A2, A3, A4, A5, A6, A7, B0, B1, B2, B3, B4, B5, B6, B7;
    bf16_t* dA = nullptr; bf16_t* dB = nullptr; int KA = 0, KB = 0;
    const int lr = tid >> 4, lc = (tid & 15) * 4;
#define TR_LD1(rr, i_) do { const int n = ntl * 64 + lc; rr = make_float4(0.f, 0.f, 0.f, 0.f); \
        if (n < N) rr = *(const float4*)(src + (size_t)(kt * 128 + lr + 16 * (i_)) * N + n); } while (0)
#define TR_LOAD(S, t_) do { TR_DECODE(t_); TR_LD1(S##0, 0); TR_LD1(S##1, 1); TR_LD1(S##2, 2); TR_LD1(S##3, 3); TR_LD1(S##4, 4); TR_LD1(S##5, 5); TR_LD1(S##6, 6); TR_LD1(S##7, 7); \
        d##S = dst + (size_t)(ntl * 64) * K + kt * 128; K##S = K; } while (0)
#define TR_ST1(rr, i_) do { float* q = T + (lr + 16 * (i_)) * 65 + lc; q[0] = rr.x; q[1] = rr.y; q[2] = rr.z; q[3] = rr.w; } while (0)
#define TR_STEP(S) do { \
        BAR_LDS(); \
        TR_ST1(S##0, 0); TR_ST1(S##1, 1); TR_ST1(S##2, 2); TR_ST1(S##3, 3); TR_ST1(S##4, 4); TR_ST1(S##5, 5); TR_ST1(S##6, 6); TR_ST1(S##7, 7); \
        bf16_t* dcur = d##S; const int Kcur = K##S; \
        BAR_LDS(); \
        { const int tn = min(tcur + 2 * tstride, E6 - 1); TR_LOAD(S, tn); }        \
        _Pragma("unroll") for (int it = 0; it < 4; ++it) { \
            const int c = tid + 256 * it, n = c >> 4, kc = c & 15; \
            const float* t = T + (8 * kc) * 65 + n; \
            uint4 o; \
            o.x = pack2(t[0 * 65], t[1 * 65]); o.y = pack2(t[2 * 65], t[3 * 65]); \
            o.z = pack2(t[4 * 65], t[5 * 65]); o.w = pack2(t[6 * 65], t[7 * 65]); \
            *(uint4*)(dcur + (size_t)n * Kcur + 8 * kc) = o; } \
        tcur += tstride; } while (0)
    const int tstride = gridDim.x * 2;
    int tcur = blockIdx.x * 2 + HALF_ID;
    { const int t0 = min(tcur, E6 - 1); TR_LOAD(A, t0); const int t1 = min(tcur + tstride, E6 - 1); TR_LOAD(B, t1); }
    while (tcur < E6) {
        TR_STEP(A);
        if (tcur < E6) TR_STEP(B);
    }
#undef TR_STEP
#undef TR_DECODE
#undef TR_LD1
#undef TR_LOAD
#undef TR_ST1
    const int gtid = blockIdx.x * 512 + threadIdx.x, gstride = gridDim.x * 512;
    bf16_t* cKA = (bf16_t*)(p.out + O_CK);
    bf16_t* cVtA = cKA + (size_t)4 * 8 * 256 * 128;
    for (int idx = gtid; idx < 4 * 8 * 256 * 128; idx += gstride) {
        const int d = idx & 127, h = (idx >> 7) & 7, s = (idx >> 10) & 255, b = idx >> 18;
        cKA[((size_t)(b * 8 + h) * 256 + s) * 128 + d] = f2bf(p.in[I_CAK][idx]);
        cVtA[((size_t)(b * 8 + h) * 128 + d) * 256 + s] = f2bf(p.in[I_CAV][idx]);
    }
    bf16_t* cKC = (bf16_t*)(p.ws + S_CKC);
    bf16_t* cVtC = (bf16_t*)(p.ws + S_CVTC);
    for (int idx = gtid; idx < 4 * 4 * 256 * 64; idx += gstride) {
        const int d = idx & 63, h = (idx >> 6) & 3, s = (idx >> 8) & 255, b = idx >> 16;
        cKC[((size_t)(b * 4 + h) * 256 + s) * 64 + d] = f2bf(p.in[I_CCK][idx]);
        cVtC[((size_t)(b * 4 + h) * 64 + d) * 256 + s] = f2bf(p.in[I_CCV][idx]);
    }
}

template <bool INBF16>
DEV void modulate_phase(const float* __restrict__ x0, const float* __restrict__ x1, const bf16_t* __restrict__ xb, const float* __restrict__ g,
                        const float* __restrict__ ada_l, int shift_idx, bf16_t* __restrict__ hout) {
    const int lane = threadIdx.x & 63, wave = threadIdx.x >> 6;
    for (int row = blockIdx.x * 8 + wave; row < NTOK; row += gridDim.x * 8) {
        const float* xr = row < NPR ? x0 + (size_t)row * DM : x1 + (size_t)(row - NPR) * DM;
        float4 v[8];
        float ss = 0.f;
#pragma unroll
        for (int i = 0; i < 8; ++i) {
            if (INBF16) { const uint2 r = *(const uint2*)(xb + (size_t)row * DM + (i * 64 + lane) * 4); v[i] = make_float4(bflo(r.x), bfhi(r.x), bflo(r.y), bfhi(r.y)); }
            else v[i] = *(const float4*)(xr + (i * 64 + lane) * 4);
            ss += v[i].x * v[i].x + v[i].y * v[i].y + v[i].z * v[i].z + v[i].w * v[i].w;
        }
#pragma unroll
        for (int o = 32; o >= 1; o >>= 1) ss += __shfl_xor(ss, o);
        const float rstd = rsqrtf(ss * (1.f / 2048.f) + 1e-6f);
        const float* sh = ada_l + (size_t)cond_of(row) * 12288 + shift_idx * 2048;
        const float* scp = sh + 2048;
#pragma unroll
        for (int i = 0; i < 8; ++i) {
            const int c = (i * 64 + lane) * 4;
            const float4 gg = *(const float4*)(g + c);
            const float4 s4 = *(const float4*)(sh + c);
            const float4 c4 = *(const float4*)(scp + c);
            uint2 o;
            o.x = pack2(v[i].x * rstd * gg.x * (1.f + c4.x) + s4.x, v[i].y * rstd * gg.y * (1.f + c4.y) + s4.y);
            o.y = pack2(v[i].z * rstd * gg.z * (1.f + c4.z) + s4.z, v[i].w * rstd * gg.w * (1.f + c4.w) + s4.w);
            *(uint2*)(hout + (size_t)row * DM + c) = o;
        }
    }
}

DEV void final_norm_phase(const bf16_t* __restrict__ xb, float* __restrict__ x, const float* __restrict__ g) {
    const int lane = threadIdx.x & 63, wave = threadIdx.x >> 6;
    for (int row = blockIdx.x * 8 + wave; row < NTOK; row += gridDim.x * 8) {
        float* xr = x + (size_t)row * DM;
        float4 v[8];
        float ss = 0.f;
#pragma unroll
        for (int i = 0; i < 8; ++i) {
            { const uint2 r = *(const uint2*)(xb + (size_t)row * DM + (i * 64 + lane) * 4); v[i] = make_float4(bflo(r.x), bfhi(r.x), bflo(r.y), bfhi(r.y)); }
            ss += v[i].x * v[i].x + v[i].y * v[i].y + v[i].z * v[i].z + v[i].w * v[i].w;
        }
#pragma unroll
        for (int o = 32; o >= 1; o >>= 1) ss += __shfl_xor(ss, o);
        const float rstd = rsqrtf(ss * (1.f / 2048.f) + 1e-6f);
#pragma unroll
        for (int i = 0; i < 8; ++i) {
            const int c = (i * 64 + lane) * 4;
            const float4 gg = *(const float4*)(g + c);
            float4 o;
            o.x = v[i].x * rstd * gg.x; o.y = v[i].y * rstd * gg.y; o.z = v[i].z * rstd * gg.z; o.w = v[i].w * rstd * gg.w;
            *(float4*)(xr + c) = o;
        }
    }
}

#define LAS __attribute__((address_space(3)))
namespace g8 {
constexpr int BM = 256, BK = 64, HALF = 128, HTB = HALF * BK * 2, NXCD = 8, WGM = 8;
DEV int lds_byte(int r, int c) { const int st = (r >> 4) * 2 + (c >> 5), rr = r & 15, cc = c & 31, ob = rr * 64 + cc * 2; return st * 1024 + (ob ^ (((ob >> 9) & 1) << 5)); }
DEV void stage_rc(int b, int& R, int& C) { const int st = b / 1024, sb = b % 1024, swz = sb ^ (((sb >> 9) & 1) << 5); R = (st >> 1) * 16 + swz / 64; C = (st & 1) * 32 + (swz % 64) / 2; }
DEV int perm32(int rho) { const int n = rho >> 4, i = rho & 15; return 8 * (i >> 2) + 4 * n + (i & 3); }
struct Unit { int pm, pn; };
struct Order {
    int nM, nN, nwg, G, c;
    DEV void init(int M, int N, int G_, int c_) { nM = M / BM; nN = N / BM; nwg = nM * nN; G = G_; c = c_; }
    DEV bool next(int i, Unit& u) const {
        const long L = (long)i * G + c; if (L >= nwg) return false;
        int wgid = (int)L; { const int q = nwg / NXCD, r = nwg % NXCD, xcd = wgid % NXCD, off = wgid / NXCD; wgid = (xcd < r ? xcd * (q + 1) : r * (q + 1) + (xcd - r) * q) + off; }
        const int nig = WGM * nN, gid = wgid / nig, fm = gid * WGM, gsz = (nM - fm) < WGM ? (nM - fm) : WGM;
        u.pm = fm + ((wgid % nig) % gsz); u.pn = (wgid % nig) / gsz; return true;
    }
};
typedef f32x4 Acc[2][2][4][2];

template <class Epi>
DEV void gemm_phase(LAS unsigned char* lds, const bf16_t* __restrict__ A, const bf16_t* __restrict__ Bt, int M, int N, int K, const Epi& E) {
    int tid = threadIdx.x;
    asm volatile("" : "+v"(tid));
    const int wid = __builtin_amdgcn_readfirstlane(tid >> 6), lane = tid & 63, wr = wid >> 2, wc = wid & 3, fr = lane & 15, fq = lane >> 4;
    const int nt = K / BK;
    Order S; S.init(M, N, (int)gridDim.x, (int)blockIdx.x);
    unsigned voffA[2], voffB[2];
#pragma unroll
    for (int i = 0; i < 2; ++i) { int R, C; stage_rc(tid * 16 + i * 8192, R, C); const int Rb = Epi::PERM ? ((R & ~31) + perm32(R & 31)) : R;
        voffA[i] = (unsigned)(R * K + C) * 2u; voffB[i] = (unsigned)(Rb * K + C) * 2u; }
    const size_t kstep = (size_t)(BK * 2);
    const size_t hstep = (size_t)HALF * K * 2;
    const size_t tstep = 2 * hstep;
    const unsigned ldsw = (unsigned)wid * 1024u;
    const int aoff = lds_byte(wr * 64 + fr, fq * 8), boff = lds_byte(wc * 32 + fr, fq * 8);
#define G8_SA(b, h) (((b) * 2 + (h)) * HTB)
#define G8_SB(b, h) ((4 + (b) * 2 + (h)) * HTB)
#define G8_STAGE_(bufoff, gbase, voff) do { _Pragma("unroll") for (int _i = 0; _i < 2; ++_i) \
        __builtin_amdgcn_global_load_lds((const unsigned*)((const char*)(gbase) + (voff)[_i]), (LAS unsigned*)(lds + (bufoff) + ldsw + _i * 8192), 16, 0, 0); } while (0)
#define G8_STAGE(bufoff, gbase) G8_STAGE_(bufoff, gbase, voffA)
#define G8_STAGEB(bufoff, gbase) G8_STAGE_(bufoff, gbase, voffB)
#define G8_LDA(dst, b, h) do { _Pragma("unroll") for (int m = 0; m < 4; ++m) _Pragma("unroll") for (int k = 0; k < 2; ++k) dst[m][k] = *(const LAS bf16x8*)(lds + G8_SA(b, h) + aoff + m * 2048 + k * 1024); } while (0)
#define G8_LDB(dst, b, h) do { _Pragma("unroll") for (int n = 0; n < 2; ++n) _Pragma("unroll") for (int k = 0; k < 2; ++k) dst[n][k] = *(const LAS bf16x8*)(lds + G8_SB(b, h) + boff + n * 2048 + k * 1024); } while (0)
#define G8_MMA(ai, bj, At, Bt_) do { __builtin_amdgcn_s_setprio(1); _Pragma("unroll") for (int m = 0; m < 4; ++m) _Pragma("unroll") for (int n = 0; n < 2; ++n) _Pragma("unroll") for (int k = 0; k < 2; ++k) \
        acc[ai][bj][m][n] = __builtin_amdgcn_mfma_f32_16x16x32_bf16(Bt_[n][k], At[m][k], acc[ai][bj][m][n], 0, 0, 0); __builtin_amdgcn_s_setprio(0); } while (0)
#define G8_WAIT_V(n) asm volatile("s_waitcnt vmcnt(" #n ")" ::: "memory")
#define G8_WAIT_L(n) asm volatile("s_waitcnt lgkmcnt(" #n ")" ::: "memory")
#define G8_BAR __builtin_amdgcn_s_barrier()
#define G8_SCHED __builtin_amdgcn_sched_barrier(0)
    Unit cur, nxt; int ui = 0;
    if (!S.next(0, cur)) return;
    Acc acc;
#pragma unroll
    for (int a = 0; a < 2; ++a)
#pragma unroll
        for (int b = 0; b < 2; ++b)
#pragma unroll
            for (int m = 0; m < 4; ++m)
#pragma unroll
                for (int n = 0; n < 2; ++n) acc[a][b][m][n] = (f32x4){0.f, 0.f, 0.f, 0.f};
    bf16x8 At[4][2], B0[2][2], B1[2][2];
    const char* cA = (const char*)A + (size_t)cur.pm * tstep; const char* cB = (const char*)Bt + (size_t)cur.pn * tstep;
    G8_STAGEB(G8_SB(0, 0), cB); G8_STAGE(G8_SA(0, 0), cA); G8_STAGEB(G8_SB(0, 1), cB + hstep); G8_STAGE(G8_SA(0, 1), cA + hstep);
    if (wr == 1) G8_BAR;
    G8_WAIT_V(4); G8_BAR;
    G8_STAGEB(G8_SB(1, 0), cB + kstep); G8_STAGE(G8_SA(1, 0), cA + kstep); G8_STAGEB(G8_SB(1, 1), cB + hstep + kstep);
    G8_WAIT_V(6); G8_BAR;
    for (;;) {
        const bool has_next = S.next(ui + 1, nxt);
        const char* nA = has_next ? (const char*)A + (size_t)nxt.pm * tstep : cA; const char* nB = has_next ? (const char*)Bt + (size_t)nxt.pn * tstep : cB;
        for (int t = 0; t < nt; t += 2) {
            const bool last = (t == nt - 2);
            const char* a1 = cA + (size_t)(t + 1) * kstep;
            const char* a2 = last ? nA : cA + (size_t)(t + 2) * kstep; const char* b2 = last ? nB : cB + (size_t)(t + 2) * kstep;
            const char* a3 = a2 + kstep; const char* b3 = b2 + kstep;
            G8_LDB(B0, 0, 0); G8_SCHED; G8_LDA(At, 0, 0); G8_STAGE(G8_SA(1, 1), a1 + hstep);
            G8_WAIT_L(8); G8_BAR; G8_WAIT_L(0); G8_MMA(0, 0, At, B0); G8_BAR; G8_SCHED;
            G8_LDB(B1, 0, 1); G8_STAGEB(G8_SB(0, 0), b2);
            G8_BAR; G8_WAIT_L(0); G8_MMA(0, 1, At, B1); G8_BAR;
            G8_LDA(At, 0, 1); G8_STAGE(G8_SA(0, 0), a2);
            G8_BAR; G8_WAIT_L(0); G8_MMA(1, 0, At, B0); G8_BAR; G8_SCHED;
            G8_STAGEB(G8_SB(0, 1), b2 + hstep);
            G8_WAIT_V(6); G8_BAR; G8_MMA(1, 1, At, B1); G8_BAR;
            G8_LDB(B0, 1, 0); G8_SCHED; G8_LDA(At, 1, 0); G8_STAGE(G8_SA(0, 1), a2 + hstep);
            G8_WAIT_L(8); G8_BAR; G8_WAIT_L(0); G8_MMA(0, 0, At, B0); G8_BAR; G8_SCHED;
            G8_LDB(B1, 1, 1); G8_STAGEB(G8_SB(1, 0), b3);
            G8_BAR; G8_WAIT_L(0); G8_MMA(0, 1, At, B1); G8_BAR;
            G8_LDA(At, 1, 1); G8_STAGE(G8_SA(1, 0), a3);
            G8_BAR; G8_WAIT_L(0); G8_MMA(1, 0, At, B0); G8_BAR; G8_SCHED;
            G8_STAGEB(G8_SB(1, 1), b3 + hstep);
            G8_WAIT_V(6); G8_BAR; G8_MMA(1, 1, At, B1); G8_BAR;
        }
        E(acc, cur, wr, wc, fr, fq);
        if (!has_next) break;
#pragma unroll
        for (int a = 0; a < 2; ++a)
#pragma unroll
            for (int b = 0; b < 2; ++b)
#pragma unroll
                for (int m = 0; m < 4; ++m)
#pragma unroll
                    for (int n = 0; n < 2; ++n) acc[a][b][m][n] = (f32x4){0.f, 0.f, 0.f, 0.f};
        cur = nxt; cA = nA; cB = nB; ++ui;
    }
    G8_WAIT_V(0);
    if (wr == 0) G8_BAR;
    G8_BAR;
#undef G8_SA
#undef G8_SB
#undef G8_STAGE
#undef G8_STAGEB
#undef G8_STAGE_
#undef G8_LDA
#undef G8_LDB
#undef G8_MMA
#undef G8_WAIT_V
#undef G8_WAIT_L
#undef G8_BAR
#undef G8_SCHED
}
}

#define EPI_LOOP_ROWS for (int ai = 0; ai < 2; ++ai) _Pragma("unroll") for (int m = 0; m < 4; ++m)
#define EPI_LOOP_COLS for (int bj = 0; bj < 2; ++bj) _Pragma("unroll") for (int n = 0; n < 2; ++n)
struct EpiProj0 {
    static constexpr bool PERM = true;
    bf16_t* PA; bf16_t* VtA; bf16_t* PB; bf16_t* PZ; float* gates; float* nak; float* nav;
    DEV void operator()(const g8::Acc& acc, const g8::Unit& u, int wr, int wc, int fr, int fq) const {
        const int colt = u.pn * 256 + wc * 32 + 8 * fq;
#pragma unroll
        EPI_LOOP_ROWS {
            const int row = u.pm * 256 + ai * 128 + wr * 64 + m * 16 + fr;
#pragma unroll
            for (int bj = 0; bj < 2; ++bj) {
                const int col = colt + bj * 128;
                const f32x4 v0 = acc[ai][bj][m][0], v1 = acc[ai][bj][m][1];
                uint4 o; o.x = pack2(v0[0], v0[1]); o.y = pack2(v0[2], v0[3]); o.z = pack2(v1[0], v1[1]); o.w = pack2(v1[2], v1[3]);
                if (col < 2048) {
                    *(uint4*)(PA + (size_t)row * 2048 + col) = o;
                    if (col >= 1024 && row < NPR) { float* d = nak + (size_t)row * 1024 + (col - 1024); *(f32x4*)d = v0; *(f32x4*)(d + 4) = v1; }
                } else if (col < 3072) {
#pragma unroll
                    for (int j = 0; j < 4; ++j) { VtA[(size_t)(col - 2048 + j) * NTOK + row] = f2bf(v0[j]); VtA[(size_t)(col - 2048 + 4 + j) * NTOK + row] = f2bf(v1[j]); }
                    if (row < NPR) { float* d = nav + (size_t)row * 1024 + (col - 2048); *(f32x4*)d = v0; *(f32x4*)(d + 4) = v1; }
                } else if (col < 6144) {
                    *(uint4*)(PB + (size_t)row * 3072 + (col - 3072)) = o;
                } else if (col < 7168) {
                    *(uint4*)(PZ + (size_t)row * 1024 + (col - 6144)) = o;
                } else if (col < ABN) {
                    float* d = gates + (size_t)row * 32 + (col - 7168); *(f32x4*)d = v0; *(f32x4*)(d + 4) = v1;
                }
            }
        }
    }
};
template <bool INF32>
struct EpiRes {
    static constexpr bool PERM = true;
    const float* xin0; const float* xin1; const bf16_t* xbin; bf16_t* xbout; const float* gate;
    DEV void operator()(const g8::Acc& acc, const g8::Unit& u, int wr, int wc, int fr, int fq) const {
        const int colt = u.pn * 256 + wc * 32 + 8 * fq;
#pragma unroll
        EPI_LOOP_ROWS {
            const int row = u.pm * 256 + ai * 128 + wr * 64 + m * 16 + fr;
            const float* xr = row < NPR ? xin0 + (size_t)row * DM : xin1 + (size_t)(row - NPR) * DM;
            const float* gr = gate + (size_t)cond_of(row) * 12288;
#pragma unroll
            for (int bj = 0; bj < 2; ++bj) {
                const int col = colt + bj * 128;
                f32x4 x0, x1;
                if (INF32) { x0 = *(const f32x4*)(xr + col); x1 = *(const f32x4*)(xr + col + 4); }
                else { const uint4 r = *(const uint4*)(xbin + (size_t)row * DM + col);
                    x0 = (f32x4){bflo(r.x), bfhi(r.x), bflo(r.y), bfhi(r.y)}; x1 = (f32x4){bflo(r.z), bfhi(r.z), bflo(r.w), bfhi(r.w)}; }
                const f32x4 g0 = *(const f32x4*)(gr + col), g1 = *(const f32x4*)(gr + col + 4);
                const f32x4 r0 = x0 + g0 * acc[ai][bj][m][0], r1 = x1 + g1 * acc[ai][bj][m][1];
                uint4 o; o.x = pack2(r0[0], r0[1]); o.y = pack2(r0[2], r0[3]); o.z = pack2(r1[0], r1[1]); o.w = pack2(r1[2], r1[3]);
                *(uint4*)(xbout + (size_t)row * DM + col) = o;
            }
        }
    }
};
struct EpiMlp1 {
    static constexpr bool PERM = true;
    bf16_t* H;
    DEV void operator()(const g8::Acc& acc, const g8::Unit& u, int wr, int wc, int fr, int fq) const {
        const int colt = u.pn * 256 + wc * 32 + 8 * fq;
#pragma unroll
        EPI_LOOP_ROWS {
            const int row = u.pm * 256 + ai * 128 + wr * 64 + m * 16 + fr;
#pragma unroll
            for (int bj = 0; bj < 2; ++bj) {
                f32x4 v0 = acc[ai][bj][m][0], v1 = acc[ai][bj][m][1];
#pragma unroll
                for (int j = 0; j < 4; ++j) { const float r0 = fmaxf(v0[j], 0.f), r1 = fmaxf(v1[j], 0.f); v0[j] = r0 * r0; v1[j] = r1 * r1; }
                uint4 o; o.x = pack2(v0[0], v0[1]); o.y = pack2(v0[2], v0[3]); o.z = pack2(v1[0], v1[1]); o.w = pack2(v1[2], v1[3]);
                *(uint4*)(H + (size_t)row * DFF + colt + bj * 128) = o;
            }
        }
    }
};
struct EpiQkv1 {
    static constexpr bool PERM = false;
    bf16_t* QK; bf16_t* VtC; float* nck; float* ncv;
    DEV void operator()(const g8::Acc& acc, const g8::Unit& u, int wr, int wc, int fr, int fq) const {
        float inv[4];
#pragma unroll
        for (int j = 0; j < 4; ++j) inv[j] = exp2f(-(float)(fq * 4 + j) * 0.830482023721841f) * 0.15915494309189535f;
#pragma unroll
        EPI_LOOP_ROWS {
            const int row = u.pm * 256 + ai * 128 + wr * 64 + m * 16 + fr;
            const bool sample = row >= NPR;
            const int tok = (row - NPR) & 4095;
            const float pos = (float)((wc & 1) ? (tok & 63) : (tok >> 6));
#pragma unroll
            for (int bj = 0; bj < 2; ++bj) {
                const int cb = u.pn * 256 + bj * 128 + wc * 32 + 4 * fq;
                const f32x4 v0 = acc[ai][bj][m][0], v1 = acc[ai][bj][m][1];
                if (cb < 2304) {
                    if (!sample && cb >= 2048) {
                        *(f32x4*)(nck + (size_t)row * 256 + (cb - 2048)) = v0;
                        *(f32x4*)(nck + (size_t)row * 256 + (cb - 2048) + 16) = v1;
                    }
                    f32x4 o0 = v0, o1 = v1;
                    if (sample) {
#pragma unroll
                        for (int j = 0; j < 4; ++j) {
                            float rev = pos * inv[j];
                            rev -= floorf(rev);
                            const float sn = __builtin_amdgcn_sinf(rev), cs = __builtin_amdgcn_cosf(rev);
                            o0[j] = v0[j] * cs - v1[j] * sn;
                            o1[j] = v1[j] * cs + v0[j] * sn;
                        }
                    }
                    uint2 w0, w1; w0.x = pack2(o0[0], o0[1]); w0.y = pack2(o0[2], o0[3]); w1.x = pack2(o1[0], o1[1]); w1.y = pack2(o1[2], o1[3]);
                    *(uint2*)(QK + (size_t)row * 2304 + cb) = w0;
                    *(uint2*)(QK + (size_t)row * 2304 + cb + 16) = w1;
                } else {
                    const int c = cb - 2304;
#pragma unroll
                    for (int j = 0; j < 4; ++j) { VtC[(size_t)(c + j) * NTOK + row] = f2bf(v0[j]); VtC[(size_t)(c + 16 + j) * NTOK + row] = f2bf(v1[j]); }
                    if (!sample) { *(f32x4*)(ncv + (size_t)row * 256 + c) = v0; *(f32x4*)(ncv + (size_t)row * 256 + c + 16) = v1; }
                }
            }
        }
    }
};

template <int MODE>
DEV void attn_item(const Params& p, int item, char* smem) {
    constexpr int HD = (MODE <= 1) ? 128 : 64;
    constexpr int KST = HD + 8;
    constexpr int NKS = HD / 32, ND = HD / 16;
    constexpr int NH = (MODE <= 1) ? 1 : 2;
    constexpr int NR = (HD == 128) ? 4 : 2;
    constexpr int KCH = HD / 8;
    bf16_t* Ks = (bf16_t*)smem;
    bf16_t* Vt = Ks + 64 * KST;
    bf16_t* Ps = Vt + HD * 72;
    float* bias_s = (float*)(Ps + 4 * 16 * 72);
    const int tid = HTID, lane = tid & 63, w = tid >> 6, fr = lane & 15, fq = lane >> 4;
    const float scale = (MODE <= 1) ? 0.08838834764831845f : 0.125f;

    const bf16_t* PA = (const bf16_t*)(p.ws + R2_PA);
    const bf16_t* VtA = (const bf16_t*)(p.ws + R2_VTA);
    const bf16_t* QKC = (const bf16_t*)(p.ws + R2_QKC);
    const bf16_t* VtC = (const bf16_t*)(p.ws + R2_VTC);
    bf16_t* O = (bf16_t*)(p.ws + R3);

    int b, h, qt, qrow0, ntot, rs = 0, r = 0, kvh = 0, kt0 = 0, nloc = 0;
    const bf16_t* qptr; int qstride;
    bf16_t* optr;
    if (MODE == 0) {
        qt = item & 3; h = (item >> 2) & 7; b = item >> 5;
        qrow0 = b * 256 + qt * 64; qptr = PA + (size_t)qrow0 * 2048 + h * 128; qstride = 2048; ntot = 4;
        optr = O + (size_t)qrow0 * 2048 + h * 128;
    } else if (MODE == 1) {
        r = item & 63; h = (item >> 6) & 7; b = item >> 9; qt = r;
        qrow0 = NPR + b * 4096 + r * 64; qptr = PA + (size_t)qrow0 * 2048 + h * 128; qstride = 2048; ntot = 12; nloc = 8;
        rs = min(max(r - 4, 0), 56);
        optr = O + (size_t)qrow0 * 2048 + h * 128;
    } else if (MODE == 2) {
        qt = item & 3; const int hg = (item >> 2) & 15; b = item >> 6; h = hg * 2; kvh = hg >> 2;
        qrow0 = b * 256 + qt * 64; qptr = QKC + (size_t)qrow0 * 2304 + h * 64; qstride = 2304; ntot = 4;
        optr = O + (size_t)qrow0 * 2048 + h * 64;
    } else {
        qt = (item >> 1) & 63; const int hg = ((item >> 7) & 7) * 2 + (item & 1); b = item >> 10; h = hg * 2; kvh = hg >> 2;
        qrow0 = NPR + b * 4096 + qt * 64; qptr = QKC + (size_t)qrow0 * 2304 + h * 64; qstride = 2304;
        kt0 = max(qt - 2, 0); nloc = min(qt + 2, 63) - kt0 + 1; ntot = nloc + 4;
        optr = O + (size_t)qrow0 * 2048 + h * 64;
    }

    const bf16_t* kptr; const bf16_t* vptr; int kstride, vstride;
#define AT_PTRS(n) do { \
        if (MODE == 0) { const int krow0 = b * 256 + (n) * 64; \
            kptr = PA + (size_t)krow0 * 2048 + 1024 + h * 128; kstride = 2048; vptr = VtA + (size_t)(h * 128) * NTOK + krow0; vstride = NTOK; } \
        else if (MODE == 1) { \
            if ((n) < 8) { const int krow0 = NPR + b * 4096 + (rs + (n)) * 64; \
                kptr = PA + (size_t)krow0 * 2048 + 1024 + h * 128; kstride = 2048; vptr = VtA + (size_t)(h * 128) * NTOK + krow0; vstride = NTOK; } \
            else { const bf16_t* cKA = (const bf16_t*)(p.out + O_CK); const bf16_t* cVtA = cKA + (size_t)4 * 8 * 256 * 128; \
                kptr = cKA + ((size_t)(b * 8 + h) * 256 + ((n) - 8) * 64) * 128; kstride = 128; \
                vptr = cVtA + (size_t)(b * 8 + h) * 128 * 256 + ((n) - 8) * 64; vstride = 256; } } \
        else if (MODE == 2) { const int krow0 = b * 256 + (n) * 64; \
            kptr = QKC + (size_t)krow0 * 2304 + 2048 + kvh * 64; kstride = 2304; vptr = VtC + (size_t)(kvh * 64) * NTOK + krow0; vstride = NTOK; } \
        else { \
            if ((n) < nloc) { const int krow0 = NPR + b * 4096 + (kt0 + (n)) * 64; \
                kptr = QKC + (size_t)krow0 * 2304 + 2048 + kvh * 64; kstride = 2304; vptr = VtC + (size_t)(kvh * 64) * NTOK + krow0; vstride = NTOK; } \
            else { const bf16_t* cKC = (const bf16_t*)(p.ws + S_CKC); const bf16_t* cVtC = (const bf16_t*)(p.ws + S_CVTC); \
                kptr = cKC + ((size_t)(b * 4 + kvh) * 256 + ((n) - nloc) * 64) * 64; kstride = 64; \
                vptr = cVtC + (size_t)(b * 4 + kvh) * 64 * 256 + ((n) - nloc) * 64; vstride = 256; } } \
    } while (0)
    const int krow = tid / KCH, kch = tid % KCH;
    const int vrow = tid >> 3, vch = tid & 7;
    uint4 kr0, kr1, kr2, kr3, vr0, vr1, vr2, vr3;
    kr2 = kr3 = vr2 = vr3 = make_uint4(0, 0, 0, 0);
#define AT_LOAD(n) do { AT_PTRS(n); \
        kr0 = *(const uint4*)(kptr + (size_t)krow * kstride + kch * 8); kr1 = *(const uint4*)(kptr + (size_t)(krow + 256 / KCH) * kstride + kch * 8); \
        vr0 = *(const uint4*)(vptr + (size_t)vrow * vstride + vch * 8); vr1 = *(const uint4*)(vptr + (size_t)(vrow + 32) * vstride + vch * 8); \
        if (NR == 4) { kr2 = *(const uint4*)(kptr + (size_t)(krow + 2 * (256 / KCH)) * kstride + kch * 8); kr3 = *(const uint4*)(kptr + (size_t)(krow + 3 * (256 / KCH)) * kstride + kch * 8); \
                       vr2 = *(const uint4*)(vptr + (size_t)(vrow + 64) * vstride + vch * 8); vr3 = *(const uint4*)(vptr + (size_t)(vrow + 96) * vstride + vch * 8); } \
    } while (0)
#define AT_STORE() do { \
        *(uint4*)(Ks + krow * KST + kch * 8) = kr0; *(uint4*)(Ks + (krow + 256 / KCH) * KST + kch * 8) = kr1; \
        *(uint4*)(Vt + vrow * 72 + vch * 8) = vr0; *(uint4*)(Vt + (vrow + 32) * 72 + vch * 8) = vr1; \
        if (NR == 4) { *(uint4*)(Ks + (krow + 2 * (256 / KCH)) * KST + kch * 8) = kr2; *(uint4*)(Ks + (krow + 3 * (256 / KCH)) * KST + kch * 8) = kr3; \
                       *(uint4*)(Vt + (vrow + 64) * 72 + vch * 8) = vr2; *(uint4*)(Vt + (vrow + 96) * 72 + vch * 8) = vr3; } \
    } while (0)

    AT_LOAD(0);
    constexpr float LOG2E = 1.4426950408889634f;
    const float c1 = scale * LOG2E;
    bf16x8 qf[NH][NKS];
    float mrow[NH], lpart[NH];
    f32x4 oacc[NH][ND];
#pragma unroll
    for (int hh = 0; hh < NH; ++hh) {
#pragma unroll
        for (int ks = 0; ks < NKS; ++ks) qf[hh][ks] = *(const bf16x8*)(qptr + (size_t)(16 * w + fr) * qstride + hh * 64 + ks * 32 + fq * 8);
        mrow[hh] = (MODE >= 2) ? p.in[I_SINK][h + hh] * LOG2E : -1e30f;
        lpart[hh] = (MODE >= 2 && fq == 0) ? 1.f : 0.f;
#pragma unroll
        for (int nd = 0; nd < ND; ++nd) oacc[hh][nd] = (f32x4){0.f, 0.f, 0.f, 0.f};
    }
    BAR_LDS();
    if (MODE == 1) { for (int i = tid; i < 465; i += 256) bias_s[i] = p.in[I_RELB][h * 465 + i] * LOG2E; }
    const int qi = 16 * w + fr;

#pragma unroll 1
    for (int n = 0; n < ntot; ++n) {
        if (n) BAR_LDS();
        AT_STORE();
        BAR_LDS();
        { const int nn = min(n + 1, ntot - 1); AT_LOAD(nn); }
        const bool local = n < nloc;
        const int dkt = (MODE == 3) ? (kt0 + n - qt) : 0;
#pragma unroll
        for (int hh = 0; hh < NH; ++hh) {
            f32x4 sacc[4];
#pragma unroll
            for (int nb = 0; nb < 4; ++nb) sacc[nb] = (f32x4){0.f, 0.f, 0.f, 0.f};
#pragma unroll
            for (int ks = 0; ks < NKS; ++ks)
#pragma unroll
                for (int nb = 0; nb < 4; ++nb) {
                    const bf16x8 kf = *(const bf16x8*)(Ks + (nb * 16 + fr) * KST + ks * 32 + fq * 8);
                    sacc[nb] = mfma16(kf, qf[hh][ks], sacc[nb]);
                }
            if (MODE == 1 && local) {
                const int cs = min(max(qi - 8, 0), 48);
                const float* brow = bias_s + (rs + n - r + 7) * 31 + 15 - qi;
#pragma unroll
                for (int nb = 0; nb < 4; ++nb)
#pragma unroll
                    for (int j = 0; j < 4; ++j) {
                        const int kj = nb * 16 + 4 * fq + j;
                        const bool ok = kj >= cs && kj < cs + 16;
                        sacc[nb][j] = ok ? sacc[nb][j] * c1 + brow[ok ? kj : qi] : -1e30f;
                    }
            } else if (MODE == 3 && local && (dkt == 2 || dkt == -2)) {
#pragma unroll
                for (int nb = 0; nb < 4; ++nb)
#pragma unroll
                    for (int j = 0; j < 4; ++j) {
                        const int dlt = dkt * 64 + nb * 16 + 4 * fq + j - qi;
                        sacc[nb][j] = (dlt > 128 || dlt < -128) ? -1e30f : sacc[nb][j] * c1;
                    }
            } else {
#pragma unroll
                for (int nb = 0; nb < 4; ++nb)
#pragma unroll
                    for (int j = 0; j < 4; ++j) sacc[nb][j] *= c1;
            }
            float mx = sacc[0][0];
#pragma unroll
            for (int nb = 0; nb < 4; ++nb)
#pragma unroll
                for (int j = 0; j < 4; ++j) mx = fmaxf(mx, sacc[nb][j]);
            mx = fmaxf(mx, __shfl_xor(mx, 16));
            mx = fmaxf(mx, __shfl_xor(mx, 32));
            const float mnew = fmaxf(mrow[hh], mx);
            const float alpha = __builtin_amdgcn_exp2f(mrow[hh] - mnew);
            mrow[hh] = mnew;
            float psum = 0.f;
#pragma unroll
            for (int nb = 0; nb < 4; ++nb)
#pragma unroll
                for (int j = 0; j < 4; ++j) { const float pv = __builtin_amdgcn_exp2f(sacc[nb][j] - mnew); sacc[nb][j] = pv; psum += pv; }
            lpart[hh] = lpart[hh] * alpha + psum;
#pragma unroll
            for (int nd = 0; nd < ND; ++nd)
#pragma unroll
                for (int j = 0; j < 4; ++j) oacc[hh][nd][j] *= alpha;
#pragma unroll
            for (int ks = 0; ks < 2; ++ks) {
                union { u32 u[4]; bf16x8 v; } pf;
                pf.u[0] = pack2(sacc[2 * ks][0], sacc[2 * ks][1]); pf.u[1] = pack2(sacc[2 * ks][2], sacc[2 * ks][3]);
                pf.u[2] = pack2(sacc[2 * ks + 1][0], sacc[2 * ks + 1][1]); pf.u[3] = pack2(sacc[2 * ks + 1][2], sacc[2 * ks + 1][3]);
#pragma unroll
                for (int nd = 0; nd < ND; ++nd) {
                    union { uint2 h2[2]; bf16x8 v; } vf;
                    vf.h2[0] = *(const uint2*)(Vt + (nd * 16 + fr) * 72 + ks * 32 + 4 * fq);
                    vf.h2[1] = *(const uint2*)(Vt + (nd * 16 + fr) * 72 + ks * 32 + 16 + 4 * fq);
                    oacc[hh][nd] = mfma16(vf.v, pf.v, oacc[hh][nd]);
                }
            }
        }
    }
#pragma unroll
    for (int hh = 0; hh < NH; ++hh) {
        float l = lpart[hh];
        l += __shfl_xor(l, 16);
        l += __shfl_xor(l, 32);
        const float linv = 1.f / l;
#pragma unroll
        for (int nd = 0; nd < ND; ++nd) {
            uint2 o;
            o.x = pack2(oacc[hh][nd][0] * linv, oacc[hh][nd][1] * linv);
            o.y = pack2(oacc[hh][nd][2] * linv, oacc[hh][nd][3] * linv);
            *(uint2*)(optr + (size_t)(16 * w + fr) * 2048 + hh * 64 + nd * 16 + 4 * fq) = o;
        }
    }
#undef AT_PTRS
#undef AT_LOAD
#undef AT_STORE
}

DEV void dn_prep_item(const Params& p, int item, char* smem) {
    const int tid = HTID, lane = tid & 63, w = tid >> 6, fr = lane & 15, fq = lane >> 4;
    const int cidx = item >> 3, h = item & 7;
    const int row0 = cidx * 64;
    int seq_start, seq_end;
    if (row0 < NPR) { seq_start = row0 & ~255; seq_end = seq_start + 256; }
    else { seq_start = NPR + ((row0 - NPR) & ~4095); seq_end = seq_start + 4096; }
    bf16_t* qs = (bf16_t*)smem;
    bf16_t* ks = qs + 64 * 136;
    bf16_t* vs = ks + 64 * 136;
    float* Ms = (float*)smem;
    float* sm_beta = (float*)(smem + 3 * 17408);
    float* sm_gc = sm_beta + 128;
    float* sm_su = sm_gc + 128;
    float* sm_sw = sm_su + 128;
    const bf16_t* PB = (const bf16_t*)(p.ws + R2_PB);
    const float* gates = (const float*)(p.ws + S_GATES);
    bf16_t* QN = (bf16_t*)(p.ws + R1_QN);
    bf16_t* KNT = (bf16_t*)(p.ws + R1_KNT);
    bf16_t* UT = (bf16_t*)(p.out);
    bf16_t* Wb = UT + (size_t)6144 * 128 * 64;
    bf16_t* QKb = (bf16_t*)(p.ws + R2_QK);
    float* GC = (float*)(p.ws + S_GC);
    const float* conv = p.in[I_CONV];

    BAR_LDS();
    {
        const int i = tid >> 2, dq = tid & 3;
        const int row = row0 + i;
        const bool hasPrev = (row - 1) >= seq_start, hasNext = (row + 1) < seq_end;
        const int offPrev = hasPrev ? -3072 : 0, offNext = hasNext ? 3072 : 0;
        auto ldpart = [&](uint4 (&x)[3][4], int part) __attribute__((always_inline)) {
            const bf16_t* px = PB + (size_t)row * 3072 + part * 1024 + h * 128 + dq * 32;
#pragma unroll
            for (int c8 = 0; c8 < 4; ++c8) {
                x[1][c8] = *(const uint4*)(px + c8 * 8);
                x[0][c8] = *(const uint4*)(px + c8 * 8 + offPrev);
                x[2][c8] = *(const uint4*)(px + c8 * 8 + offNext);
            }
        };
        auto do_part = [&](const uint4 (&x)[3][4], int part) __attribute__((always_inline)) {
            const int colbase = part * 1024 + h * 128 + dq * 32;
            float y[32];
            float ss = 0.f;
#pragma unroll
            for (int c8 = 0; c8 < 4; ++c8) {
                const uint4 x1 = x[1][c8];
                const uint4 x0 = hasPrev ? x[0][c8] : make_uint4(0, 0, 0, 0), x2 = hasNext ? x[2][c8] : make_uint4(0, 0, 0, 0);
                const float* wq = conv + colbase + c8 * 8;
                const u32 a0[4] = {x0.x, x0.y, x0.z, x0.w}, a1[4] = {x1.x, x1.y, x1.z, x1.w}, a2[4] = {x2.x, x2.y, x2.z, x2.w};
#pragma unroll
                for (int e2 = 0; e2 < 4; ++e2) {
                    const float2 w0 = *(const float2*)(wq + 2 * e2), w1 = *(const float2*)(wq + 3072 + 2 * e2), w2 = *(const float2*)(wq + 6144 + 2 * e2);
                    const float va = w0.x * bflo(a0[e2]) + w1.x * bflo(a1[e2]) + w2.x * bflo(a2[e2]);
                    const float vb = w0.y * bfhi(a0[e2]) + w1.y * bfhi(a1[e2]) + w2.y * bfhi(a2[e2]);
                    const float ya = siluf(va), yb = siluf(vb);
                    y[c8 * 8 + 2 * e2] = ya; y[c8 * 8 + 2 * e2 + 1] = yb;
                    ss += ya * ya + yb * yb;
                }
            }
            float sc = 1.f;
            if (part < 2) {
                ss += __shfl_xor(ss, 1); ss += __shfl_xor(ss, 2);
                sc = rsqrtf(ss + 1e-6f) * (part == 0 ? 0.08838834764831845f : 1.f);
            }
            bf16_t* dst = (part == 0 ? qs : (part == 1 ? ks : vs)) + i * 136 + dq * 32;
#pragma unroll
            for (int c8 = 0; c8 < 4; ++c8) {
                uint4 o;
                o.x = pack2(y[c8 * 8 + 0] * sc, y[c8 * 8 + 1] * sc); o.y = pack2(y[c8 * 8 + 2] * sc, y[c8 * 8 + 3] * sc);
                o.z = pack2(y[c8 * 8 + 4] * sc, y[c8 * 8 + 5] * sc); o.w = pack2(y[c8 * 8 + 6] * sc, y[c8 * 8 + 7] * sc);
                *(uint4*)(dst + c8 * 8) = o;
                if (part == 0) *(uint4*)(QN + ((size_t)(cidx * 8 + h) * 64 + i) * 128 + dq * 32 + c8 * 8) = o;
            }
        };
        uint4 xa[3][4], xb[3][4];
        ldpart(xa, 0);
        ldpart(xb, 1);
        do_part(xa, 0);
        ldpart(xa, 2);
        do_part(xb, 1);
        do_part(xa, 2);
    }
    if (tid < 128) {
        const int dir = tid >> 6, ii = tid & 63;
        const int rr = row0 + (dir ? 63 - ii : ii);
        const float braw = gates[(size_t)rr * 32 + dir * 8 + h], araw = gates[(size_t)rr * 32 + 16 + dir * 8 + h];
        const float beta = 1.f / (1.f + __expf(-braw));
        const float xx = araw + p.in[I_DTB][dir * 8 + h];
        const float sp = xx > 20.f ? xx : log1pf(__expf(xx));
        const float gval = -__expf(p.in[I_ALOG][dir * 8 + h]) * sp;
        float c = gval;
#pragma unroll
        for (int o = 1; o < 64; o <<= 1) { const float tt = __shfl_up(c, o); if (ii >= o) c += tt; }
        sm_beta[dir * 64 + ii] = beta; sm_gc[dir * 64 + ii] = c;
        sm_su[dir * 64 + ii] = beta; sm_sw[dir * 64 + ii] = beta * __expf(c);
        GC[((size_t)(cidx * 8 + h) * 2 + dir) * 64 + ii] = c;
    }
    BAR_LDS();
    {
#pragma unroll
        for (int i = 0; i < 4; ++i) {
            const int pc = tid + 256 * i, dk = pc >> 3, c8 = (pc & 7) * 8;
            const bf16_t* src = ks + c8 * 136 + dk;
            uint4 o;
            o.x = (u32)src[0] | ((u32)src[136] << 16); o.y = (u32)src[2 * 136] | ((u32)src[3 * 136] << 16);
            o.z = (u32)src[4 * 136] | ((u32)src[5 * 136] << 16); o.w = (u32)src[6 * 136] | ((u32)src[7 * 136] << 16);
            *(uint4*)(KNT + ((size_t)(cidx * 8 + h) * 128 + dk) * 64 + c8) = o;
        }
    }
    {
        f32x4 qk[4];
#pragma unroll
        for (int nb = 0; nb < 4; ++nb) qk[nb] = (f32x4){0.f, 0.f, 0.f, 0.f};
#pragma unroll
        for (int k4 = 0; k4 < 4; ++k4) {
            const bf16x8 aq = *(const bf16x8*)(qs + (16 * w + fr) * 136 + k4 * 32 + fq * 8);
#pragma unroll
            for (int nb = 0; nb < 4; ++nb) {
                const bf16x8 bk = *(const bf16x8*)(ks + (nb * 16 + fr) * 136 + k4 * 32 + fq * 8);
                qk[nb] = mfma16(aq, bk, qk[nb]);
            }
        }
#pragma unroll
        for (int dir = 0; dir < 2; ++dir) {
            const size_t ib = (size_t)(cidx * 8 + h) * 2 + dir;
#pragma unroll
            for (int nb = 0; nb < 4; ++nb)
#pragma unroll
                for (int j = 0; j < 4; ++j) {
                    const int io = 16 * w + 4 * fq + j, jo = nb * 16 + fr;
                    const int ip = dir ? 63 - io : io, jp = dir ? 63 - jo : jo;
                    const float dec = __expf(fminf(sm_gc[dir * 64 + ip] - sm_gc[dir * 64 + jp], 0.f));
                    QKb[(ib * 64 + ip) * 64 + jp] = f2bf((ip >= jp) ? qk[nb][j] * dec : 0.f);
                }
        }
    }
    BAR_LDS();
#pragma unroll 1
    for (int dir = 0; dir < 2; ++dir) {
        const size_t ib = (size_t)(cidx * 8 + h) * 2 + dir;
        {
            f32x4 kk[4];
#pragma unroll
            for (int nb = 0; nb < 4; ++nb) kk[nb] = (f32x4){0.f, 0.f, 0.f, 0.f};
#pragma unroll
            for (int k4 = 0; k4 < 4; ++k4) {
                const bf16x8 ak = *(const bf16x8*)(ks + (16 * w + fr) * 136 + k4 * 32 + fq * 8);
#pragma unroll
                for (int nb = 0; nb < 4; ++nb) {
                    const bf16x8 bk = *(const bf16x8*)(ks + (nb * 16 + fr) * 136 + k4 * 32 + fq * 8);
                    kk[nb] = mfma16(ak, bk, kk[nb]);
                }
            }
#pragma unroll
            for (int nb = 0; nb < 4; ++nb)
#pragma unroll
                for (int j = 0; j < 4; ++j) {
                    const int io = 16 * w + 4 * fq + j, jo = nb * 16 + fr;
                    const int ip = dir ? 63 - io : io, jp = dir ? 63 - jo : jo;
                    const float dec = __expf(fminf(sm_gc[dir * 64 + ip] - sm_gc[dir * 64 + jp], 0.f));
                    Ms[ip * 68 + jp] = (ip > jp) ? sm_beta[dir * 64 + ip] * kk[nb][j] * dec : 0.f;
                }
        }
        BAR_LDS();
        {
            const bool isU = tid < 128;
            const int col = tid & 127;
            const bf16_t* src = isU ? vs : ks;
            const float* scl = (isU ? sm_su : sm_sw) + dir * 64;
            float x[64];
            f32x4 mc[16], mn[16];
            float rc = bf2f(src[(dir ? 63 : 0) * 136 + col]) * scl[0], rn = 0.f;
#pragma unroll
            for (int i = 0; i < 64; ++i) {
                if (i + 1 < 64) {
                    const int pos = dir ? 62 - i : i + 1;
                    rn = bf2f(src[pos * 136 + col]) * scl[i + 1];
#pragma unroll
                    for (int q = 0; q < (i + 4) / 4; ++q) mn[q] = *(const f32x4*)(Ms + (i + 1) * 68 + 4 * q);
                }
                asm volatile("" ::: "memory");
                float a = rc;
#pragma unroll
                for (int j = 0; j < i; ++j) a -= mc[j >> 2][j & 3] * x[j];
                x[i] = a;
                rc = rn;
#pragma unroll
                for (int q = 0; q < (i + 4) / 4; ++q) mc[q] = mn[q];
            }
            BAR_LDS();
            bf16_t* XT = (bf16_t*)Ms;
            if (isU) {
#pragma unroll
                for (int g4 = 0; g4 < 16; ++g4) {
                    uint2 o; o.x = pack2(x[g4 * 4 + 0], x[g4 * 4 + 1]); o.y = pack2(x[g4 * 4 + 2], x[g4 * 4 + 3]);
                    *(uint2*)(XT + col * 68 + g4 * 4) = o;
                }
            } else {
                bf16_t* dst = Wb + (ib * 64) * 128 + col;
#pragma unroll
                for (int i = 0; i < 64; ++i) dst[i * 128] = f2bf(x[i]);
            }
            BAR_LDS();
            {
                bf16_t* dst = UT + (ib * 128) * 64;
#pragma unroll
                for (int i = 0; i < 4; ++i) {
                    const int pc = tid + 256 * i, rw = pc >> 3, c8 = (pc & 7) * 8;
                    const uint2 lo = *(const uint2*)(XT + rw * 68 + c8), hi = *(const uint2*)(XT + rw * 68 + c8 + 4);
                    *(uint4*)(dst + rw * 64 + c8) = make_uint4(lo.x, lo.y, hi.x, hi.y);
                }
            }
        }
        BAR_LDS();
    }
}

DEV void dn_scan_item(const Params& p, int chain, bool sample, char* smem) {
    const int tid = HTID, lane = tid & 63, w = tid >> 6, fr = lane & 15, fq = lane >> 4;
    const int slice = HALF_ID;
    const int dir = chain & 1, h = (chain >> 1) & 7, sq = chain >> 4;
    const int nch = sample ? 64 : 4;
    const int cbase = sample ? 128 + sq * 64 : sq * 4;
    bf16_t* Ss = (bf16_t*)smem;
    bf16_t* VNs = Ss + 64 * 136;
    bf16_t* VSs = VNs + 64 * 72;
    bf16_t* Os = VSs + 64 * 72;
    const bf16_t* QN = (const bf16_t*)(p.ws + R1_QN);
    const bf16_t* KNT = (const bf16_t*)(p.ws + R1_KNT);
    const bf16_t* UT = (const bf16_t*)(p.out);
    const bf16_t* Wb = UT + (size_t)6144 * 128 * 64;
    const bf16_t* QKb = (const bf16_t*)(p.ws + R2_QK);
    const float* GC = (const float*)(p.ws + S_GC);
    bf16_t* OB = (bf16_t*)(p.ws + R2_PB);

    f32x4 sacc[2][4];
#pragma unroll
    for (int rt = 0; rt < 2; ++rt)
#pragma unroll
        for (int ct = 0; ct < 4; ++ct) {
            if (sample) {
                const float* src = p.in[dir ? I_SBB : I_SBF] + (size_t)(sq * 8 + h) * 128 * 128;
#pragma unroll
                for (int j = 0; j < 4; ++j) sacc[rt][ct][j] = src[(size_t)(32 * w + 16 * rt + 4 * fq + j) * 128 + slice * 64 + 16 * ct + fr];
            } else sacc[rt][ct] = (f32x4){0.f, 0.f, 0.f, 0.f};
        }
    BAR_LDS();
#pragma unroll
    for (int rt = 0; rt < 2; ++rt)
#pragma unroll
        for (int ct = 0; ct < 4; ++ct) {
            uint2 o; o.x = pack2(sacc[rt][ct][0], sacc[rt][ct][1]); o.y = pack2(sacc[rt][ct][2], sacc[rt][ct][3]);
            *(uint2*)(Ss + (16 * ct + fr) * 136 + 32 * w + 16 * rt + 4 * fq) = o;
        }
    const int ipA = 16 * w + fr;
    const int posA = dir ? 63 - ipA : ipA;
    const int i0 = 16 * w + 4 * fq;
    struct ScanOps { bf16x8 wf[4], qf[4]; uint2 uf[4]; float4 gc4; float glast; int row0; };
    auto scan_load = [&](ScanOps& o, int s) __attribute__((always_inline)) {
        const int cs = dir ? nch - 1 - s : s;
        const int cidx = cbase + cs, row0 = cidx * 64;
        const size_t ib = (size_t)(cidx * 8 + h) * 2 + dir;
        o.row0 = row0;
#pragma unroll
        for (int k4 = 0; k4 < 4; ++k4) {
            o.wf[k4] = *(const bf16x8*)(Wb + (ib * 64 + ipA) * 128 + k4 * 32 + fq * 8);
            o.qf[k4] = *(const bf16x8*)(QN + ((size_t)(cidx * 8 + h) * 64 + posA) * 128 + k4 * 32 + fq * 8);
        }
#pragma unroll
        for (int ct = 0; ct < 4; ++ct) o.uf[ct] = *(const uint2*)(UT + (ib * 128 + slice * 64 + 16 * ct + fr) * 64 + i0);
        o.gc4 = *(const float4*)(GC + ib * 64 + i0);
        o.glast = GC[ib * 64 + 63];
    };
    int orow_prev = 0;
    ScanOps nxt;
    scan_load(nxt, 0);
#pragma unroll 1
    for (int s = 0; s < nch; ++s) {
        const ScanOps cur = nxt;
        scan_load(nxt, min(s + 1, nch - 1));
        const int row0 = cur.row0;
        bf16x8 qkf[2], knf[2][2];
        {
            const int cidx = row0 >> 6;
            const size_t ib = (size_t)(cidx * 8 + h) * 2 + dir;
#pragma unroll
            for (int k2 = 0; k2 < 2; ++k2) {
                qkf[k2] = *(const bf16x8*)(QKb + (ib * 64 + ipA) * 64 + k2 * 32 + fq * 8);
#pragma unroll
                for (int rt = 0; rt < 2; ++rt)
                    knf[rt][k2] = *(const bf16x8*)(KNT + ((size_t)(cidx * 8 + h) * 128 + 32 * w + 16 * rt + fr) * 64 + k2 * 32 + fq * 8);
            }
        }
        const float glast = cur.glast;
        const float gcv[4] = {cur.gc4.x, cur.gc4.y, cur.gc4.z, cur.gc4.w};
#define wf cur.wf
#define qf cur.qf
#define uf cur.uf
        BAR_LDS();
        if (s > 0) {
#pragma unroll
            for (int i = 0; i < 2; ++i) {
                const int pc = tid + 256 * i, tk = pc >> 3, c8 = (pc & 7) * 8;
                *(uint4*)(OB + ((size_t)dir * NTOK + orow_prev + tk) * 1024 + h * 128 + slice * 64 + c8) = *(const uint4*)(Os + tk * 72 + c8);
            }
        }
        f32x4 wsv[4], qsv[4];
#pragma unroll
        for (int ct = 0; ct < 4; ++ct) { wsv[ct] = (f32x4){0.f, 0.f, 0.f, 0.f}; qsv[ct] = (f32x4){0.f, 0.f, 0.f, 0.f}; }
#pragma unroll
        for (int k4 = 0; k4 < 4; ++k4) {
            bf16x8 sf[4];
#pragma unroll
            for (int ct = 0; ct < 4; ++ct) sf[ct] = *(const bf16x8*)(Ss + (16 * ct + fr) * 136 + k4 * 32 + fq * 8);
            asm volatile("" ::: "memory");
#pragma unroll
            for (int ct = 0; ct < 4; ++ct) {
                wsv[ct] = mfma16(wf[k4], sf[ct], wsv[ct]);
                qsv[ct] = mfma16(qf[k4], sf[ct], qsv[ct]);
            }
        }
        float ek[4], eg[4];
#pragma unroll
        for (int j = 0; j < 4; ++j) { ek[j] = __expf(glast - gcv[j]); eg[j] = __expf(gcv[j]); }
#pragma unroll
        for (int ct = 0; ct < 4; ++ct) {
            float vn[4];
            vn[0] = bflo(uf[ct].x) - wsv[ct][0]; vn[1] = bfhi(uf[ct].x) - wsv[ct][1];
            vn[2] = bflo(uf[ct].y) - wsv[ct][2]; vn[3] = bfhi(uf[ct].y) - wsv[ct][3];
            uint2 o; o.x = pack2(vn[0], vn[1]); o.y = pack2(vn[2], vn[3]);
            *(uint2*)(VNs + (16 * ct + fr) * 72 + i0) = o;
            uint2 o2;
            if (dir == 0) { o2.x = pack2(vn[0] * ek[0], vn[1] * ek[1]); o2.y = pack2(vn[2] * ek[2], vn[3] * ek[3]);
                *(uint2*)(VSs + (16 * ct + fr) * 72 + i0) = o2; }
            else { o2.x = pack2(vn[3] * ek[3], vn[2] * ek[2]); o2.y = pack2(vn[1] * ek[1], vn[0] * ek[0]);
                *(uint2*)(VSs + (16 * ct + fr) * 72 + 60 - i0) = o2; }
        }
        BAR_LDS();
        bf16x8 vnf[4][2], vsf[4][2];
#pragma unroll
        for (int ct = 0; ct < 4; ++ct)
#pragma unroll
            for (int k2 = 0; k2 < 2; ++k2) vnf[ct][k2] = *(const bf16x8*)(VNs + (16 * ct + fr) * 72 + k2 * 32 + fq * 8);
#pragma unroll
        for (int ct = 0; ct < 4; ++ct)
#pragma unroll
            for (int k2 = 0; k2 < 2; ++k2) vsf[ct][k2] = *(const bf16x8*)(VSs + (16 * ct + fr) * 72 + k2 * 32 + fq * 8);
        asm volatile("" ::: "memory");
#pragma unroll
        for (int ct = 0; ct < 4; ++ct) {
            f32x4 oa;
#pragma unroll
            for (int j = 0; j < 4; ++j) oa[j] = qsv[ct][j] * eg[j];
#pragma unroll
            for (int k2 = 0; k2 < 2; ++k2) oa = mfma16(qkf[k2], vnf[ct][k2], oa);
#pragma unroll
            for (int j = 0; j < 4; ++j) {
                const int ip = i0 + j, pos = dir ? 63 - ip : ip;
                Os[pos * 72 + 16 * ct + fr] = f2bf(oa[j]);
            }
        }
        orow_prev = row0;
        const float cd = __expf(glast);
#pragma unroll
        for (int rt = 0; rt < 2; ++rt)
#pragma unroll
            for (int ct = 0; ct < 4; ++ct) {
#pragma unroll
                for (int j = 0; j < 4; ++j) sacc[rt][ct][j] *= cd;
#pragma unroll
                for (int k2 = 0; k2 < 2; ++k2) sacc[rt][ct] = mfma16(knf[rt][k2], vsf[ct][k2], sacc[rt][ct]);
                uint2 o; o.x = pack2(sacc[rt][ct][0], sacc[rt][ct][1]); o.y = pack2(sacc[rt][ct][2], sacc[rt][ct][3]);
                *(uint2*)(Ss + (16 * ct + fr) * 136 + 32 * w + 16 * rt + 4 * fq) = o;
            }
    }
#undef wf
#undef qf
#undef uf
    BAR_LDS();
#pragma unroll
    for (int i = 0; i < 2; ++i) {
        const int pc = tid + 256 * i, tk = pc >> 3, c8 = (pc & 7) * 8;
        *(uint4*)(OB + ((size_t)dir * NTOK + orow_prev + tk) * 1024 + h * 128 + slice * 64 + c8) = *(const uint4*)(Os + tk * 72 + c8);
    }
    if (!sample) {
        float* dst = p.out + (dir ? O_BB : O_BF) + (size_t)(sq * 8 + h) * 128 * 128;
#pragma unroll
        for (int rt = 0; rt < 2; ++rt)
#pragma unroll
            for (int ct = 0; ct < 4; ++ct)
#pragma unroll
                for (int j = 0; j < 4; ++j) dst[(size_t)(32 * w + 16 * rt + 4 * fq + j) * 128 + slice * 64 + 16 * ct + fr] = sacc[rt][ct][j];
    }
}

DEV void dn_final_phase(const Params& p) {
    const int lane = threadIdx.x & 63, wave = threadIdx.x >> 6;
    const bf16_t* OB = (const bf16_t*)(p.ws + R2_PB);
    const bf16_t* PZ = (const bf16_t*)(p.ws + R2_PZ);
    bf16_t* O = (bf16_t*)(p.ws + R3);
    const float* gn = p.in[I_ONORM];
    for (int row = blockIdx.x * 8 + wave; row < NTOK; row += gridDim.x * 8) {
        const int c0 = lane * 16;
        float v[16];
        float ss = 0.f;
#pragma unroll
        for (int hh = 0; hh < 2; ++hh) {
            const uint4 a = *(const uint4*)(OB + (size_t)row * 1024 + c0 + hh * 8);
            const uint4 b = *(const uint4*)(OB + ((size_t)NTOK + row) * 1024 + c0 + hh * 8);
            const u32 aa[4] = {a.x, a.y, a.z, a.w}, bb[4] = {b.x, b.y, b.z, b.w};
#pragma unroll
            for (int e = 0; e < 4; ++e) {
                const float lo = bflo(aa[e]) + bflo(bb[e]), hi = bfhi(aa[e]) + bfhi(bb[e]);
                v[hh * 8 + 2 * e] = lo; v[hh * 8 + 2 * e + 1] = hi;
                ss += lo * lo + hi * hi;
            }
        }
        ss += __shfl_xor(ss, 1); ss += __shfl_xor(ss, 2); ss += __shfl_xor(ss, 4);
        const float rstd = rsqrtf(ss * (1.f / 128.f) + 1e-6f);
#pragma unroll
        for (int hh = 0; hh < 2; ++hh) {
            const uint4 z = *(const uint4*)(PZ + (size_t)row * 1024 + c0 + hh * 8);
            const u32 zz[4] = {z.x, z.y, z.z, z.w};
            u32 o[4];
#pragma unroll
            for (int e = 0; e < 4; ++e) {
                const int d = (c0 + hh * 8 + 2 * e) & 127;
                const float lo = v[hh * 8 + 2 * e] * rstd * gn[d] * siluf(bflo(zz[e]));
                const float hi = v[hh * 8 + 2 * e + 1] * rstd * gn[d + 1] * siluf(bfhi(zz[e]));
                o[e] = pack2(lo, hi);
            }
            *(uint4*)(O + (size_t)row * 2048 + 1024 + c0 + hh * 8) = make_uint4(o[0], o[1], o[2], o[3]);
        }
    }
}

__global__ void __launch_bounds__(512) mega(Params p) {
    cg::grid_group grid = cg::this_grid();
    extern __shared__ __attribute__((aligned(16))) unsigned char dyn_lds[];
    LAS unsigned char* glds = (LAS unsigned char*)dyn_lds;
#define smem ((char*)dyn_lds + HALF_ID * HSMEM)
    int* s_item = (int*)((char*)dyn_lds + STAGE_LDS);
    float* ada = (float*)(p.ws + S_ADA);
    bf16_t* Xb = (bf16_t*)p.out;
    bf16_t* Xlast = (bf16_t*)(p.ws + R3);
    int ph = 0;
    unsigned* gbar = (unsigned*)(p.ws + S_BAR);
    const unsigned my_xcc = xcc_id();
    if (threadIdx.x == 0) __hip_atomic_fetch_add(gbar + 64 * my_xcc, 1u, __ATOMIC_RELAXED, __HIP_MEMORY_SCOPE_AGENT);
    unsigned n_here = 0, n_xcc = 0;
#define SYNC_OR_STOP() do { if (++ph > PHASE_STOP) return; \
        if (ph == 1) { grid.sync(); n_here = __hip_atomic_load(gbar + 64 * my_xcc, __ATOMIC_RELAXED, __HIP_MEMORY_SCOPE_AGENT); \
            _Pragma("unroll") for (int j = 0; j < 8; ++j) n_xcc += __hip_atomic_load(gbar + 64 * j, __ATOMIC_RELAXED, __HIP_MEMORY_SCOPE_AGENT) != 0u; } \
        else grid_barrier(gbar, (unsigned)(ph - 1), n_here, n_xcc, my_xcc); } while (0)

    phase0(p, smem);
    SYNC_OR_STOP();
    modulate_phase<false>(p.in[I_XP], p.in[I_XS], nullptr, p.in[I_NMIX], ada, 0, (bf16_t*)(p.ws + R1));
    SYNC_OR_STOP();
    {
        EpiProj0 e{(bf16_t*)(p.ws + R2_PA), (bf16_t*)(p.ws + R2_VTA), (bf16_t*)(p.ws + R2_PB), (bf16_t*)(p.ws + R2_PZ),
                   (float*)(p.ws + S_GATES), p.out + O_AK, p.out + O_AV};
        g8::gemm_phase(glds, (const bf16_t*)(p.ws + R1), (const bf16_t*)(p.ws + W_ABIN), NTOK, ABNP, DM, e);
    }
    SYNC_OR_STOP();
    for (int it = blockIdx.x * 2 + HALF_ID; it < 3072; it += gridDim.x * 2) dn_prep_item(p, it, smem);
    SYNC_OR_STOP();
    {
        int* ctr0 = (int*)(p.ws + S_CTR);
        int steal = 0;
        for (;;) {
            const int xcd = (int)((my_xcc + (unsigned)steal) & 7u);
            BAR_LDS();
            if (threadIdx.x == 0) *s_item = atomicAdd(ctr0 + xcd * 16, 1);
            BAR_LDS();
            const int q = *s_item;
            if (q >= 264) { if (++steal >= 8) break; continue; }
            if (q < 8) dn_scan_item(p, xcd * 8 + q, true, smem);
            else if (q < 72) dn_scan_item(p, xcd * 64 + (q - 8), false, smem);
            else if (q < 200) attn_item<1>(p, (xcd * 128 + (q - 72)) * 2 + HALF_ID, smem);
            else attn_item<0>(p, (xcd * 64 + (q - 200)) * 2 + HALF_ID, smem);
        }
    }
    SYNC_OR_STOP();
    dn_final_phase(p);
    SYNC_OR_STOP();
    {
        EpiRes<true> e{p.in[I_XP], p.in[I_XS], nullptr, Xb, ada + 2 * 2048};
        g8::gemm_phase(glds, (const bf16_t*)(p.ws + R3), (const bf16_t*)(p.ws + W_ABOUT), NTOK, DM, DM, e);
    }
    SYNC_OR_STOP();
    modulate_phase<true>(nullptr, nullptr, Xb, p.in[I_NMLP], ada, 3, (bf16_t*)(p.ws + R1));
    SYNC_OR_STOP();
    {
        EpiMlp1 e{(bf16_t*)(p.ws + R2)};
        g8::gemm_phase(glds, (const bf16_t*)(p.ws + R1), (const bf16_t*)(p.ws + W_MLPIN), NTOK, DFF, DM, e);
    }
    SYNC_OR_STOP();
    {
        EpiRes<false> e{nullptr, nullptr, Xb, Xb, ada + 5 * 2048};
        g8::gemm_phase(glds, (const bf16_t*)(p.ws + R2), (const bf16_t*)(p.ws + W_MLPOUT), NTOK, DM, DFF, e);
    }
    SYNC_OR_STOP();
    const float* ada1 = ada + 5 * 12288;
    modulate_phase<true>(nullptr, nullptr, Xb, p.in[I_NMIX] + DM, ada1, 0, (bf16_t*)(p.ws + R1));
    SYNC_OR_STOP();
    {
        EpiQkv1 e{(bf16_t*)(p.ws + R2_QKC), (bf16_t*)(p.ws + R2_VTC), p.out + O_CK, p.out + O_CV};
        g8::gemm_phase(glds, (const bf16_t*)(p.ws + R1), (const bf16_t*)(p.ws + W_CQKV), NTOK, 2560, DM, e);
    }
    SYNC_OR_STOP();
    {
        const int vb = (blockIdx.x & 7) * (gridDim.x >> 3) + (blockIdx.x >> 3);
        for (int it = vb * 2 + HALF_ID; it < 4096 + 2048; it += gridDim.x * 2) {
            if (it < 4096) attn_item<3>(p, it, smem); else attn_item<2>(p, it - 4096, smem);
        }
    }
    SYNC_OR_STOP();
    {
        EpiRes<false> e{nullptr, nullptr, Xb, Xb, ada1 + 2 * 2048};
        g8::gemm_phase(glds, (const bf16_t*)(p.ws + R3), (const bf16_t*)(p.ws + W_COUT), NTOK, DM, DM, e);
    }
    SYNC_OR_STOP();
    modulate_phase<true>(nullptr, nullptr, Xb, p.in[I_NMLP] + DM, ada1, 3, (bf16_t*)(p.ws + R1));
    SYNC_OR_STOP();
    {
        EpiMlp1 e{(bf16_t*)(p.ws + R2)};
        g8::gemm_phase(glds, (const bf16_t*)(p.ws + R1), (const bf16_t*)(p.ws + W_MLPIN + SZ_MLP), NTOK, DFF, DM, e);
    }
    SYNC_OR_STOP();
    {
        EpiRes<false> e{nullptr, nullptr, Xb, Xlast, ada1 + 5 * 2048};
        g8::gemm_phase(glds, (const bf16_t*)(p.ws + R2), (const bf16_t*)(p.ws + W_MLPOUT + SZ_MLP), NTOK, DM, DFF, e);
    }
    SYNC_OR_STOP();
    final_norm_phase(Xlast, p.out, p.in[I_FNORM]);
}

extern "C" void kernel_launch(void* const* d_in, const int* in_sizes, int n_in, void* d_out, int out_size, void* d_ws, size_t ws_size,
                              hipStream_t stream) {
    static int grid_blocks = 0;
    if (grid_blocks == 0) {
        int dev = 0, cus = 0, per_cu = 0;
        (void)hipGetDevice(&dev);
        (void)hipDeviceGetAttribute(&cus, hipDeviceAttributeMultiprocessorCount, dev);
        hipError_t ea = hipFuncSetAttribute((const void*)mega, hipFuncAttributeMaxDynamicSharedMemorySize, DYN_LDS);
        (void)hipOccupancyMaxActiveBlocksPerMultiprocessor(&per_cu, (const void*)mega, 512, DYN_LDS);
        if (per_cu < 1) fprintf(stderr, "kernel_launch: occupancy query says %d blocks/CU\n", per_cu);
        grid_blocks = cus;
        if (ea != hipSuccess || n_in != 27 || ws_size < WS_TOTAL || (cus & 7) != 0) {
            fprintf(stderr, "kernel_launch: need 27 inputs and %zu bytes of workspace, got %d / %zu (attr %d, cus %d)\n", (size_t)WS_TOTAL, n_in, ws_size, (int)ea, cus);
            grid_blocks = -1;
        }
    }
    if (grid_blocks < 0) return;
    Params p;
    memset(&p, 0, sizeof(p));
    for (int i = 0; i < 27; ++i) p.in[i] = (const float*)d_in[i];
    p.out = (float*)d_out;
    p.ws = (char*)d_ws;
    (void)hipMemsetAsync((char*)d_ws + S_ADA, 0, 2 * 5 * 12288 * 4 + 8192, stream);
    void* args[] = {&p};
    hipError_t e = hipLaunchCooperativeKernel((const void*)mega, dim3(grid_blocks), dim3(512), args, DYN_LDS, stream);
    if (e != hipSuccess) fprintf(stderr, "cooperative launch failed: %s (grid %d)\n", hipGetErrorString(e), grid_blocks);
}
```

```cpp
#include <hip/hip_runtime.h>
#include <hip/hip_cooperative_groups.h>
#include <cstdio>
#include <cstring>
namespace cg = cooperative_groups;

typedef unsigned short bf16_t;
typedef short bf16x8 __attribute__((ext_vector_type(8)));
typedef float f32x4 __attribute__((ext_vector_type(4)));
typedef unsigned int u32;

#define DEV __device__ __forceinline__
#define BAR_LDS() asm volatile("s_waitcnt lgkmcnt(0)\n\ts_barrier" ::: "memory")
#ifndef PHASE_STOP
#define PHASE_STOP 99
#endif

constexpr int NT = 256;
constexpr int DM = 2048;
constexpr int NTOK = 24576;
constexpr int NPR = 8192;
constexpr int DFF = 8192;
constexpr int ABN = 7200, ABNP = 7424;
constexpr int HSMEM = 56 * 1024;
constexpr int STAGE_LDS = 131072;
constexpr int DYN_LDS = STAGE_LDS + 64;
DEV int opaque_htid() { int t = (int)(threadIdx.x & 255); asm volatile("" : "+v"(t)); return t; }
#define HTID (opaque_htid())
#define HALF_ID (__builtin_amdgcn_readfirstlane((int)(threadIdx.x >> 8)))

enum { I_XP = 0, I_XS, I_CAK, I_CAV, I_SBF, I_SBB, I_CCK, I_CCV, I_C, I_CCTX, I_WADA, I_BADA, I_NMIX, I_NMLP,
       I_WMI, I_WMO, I_ABWI, I_ABWO, I_RELB, I_CONV, I_ALOG, I_DTB, I_ONORM, I_CWQKV, I_CWO, I_SINK, I_FNORM };

constexpr size_t O_YP = 0, O_YS = 16777216, O_AK = 50331648, O_AV = 58720256, O_BF = 67108864, O_BB = 71303168,
                 O_CK = 75497472, O_CV = 77594624;

constexpr size_t SZ_ABIN = (size_t)ABNP * DM * 2, SZ_SQ = (size_t)DM * DM * 2, SZ_CQKV = (size_t)2560 * DM * 2,
                 SZ_MLP = (size_t)DFF * DM * 2;
constexpr size_t W_ABIN = 0;
constexpr size_t W_ABOUT = W_ABIN + SZ_ABIN;
constexpr size_t W_CQKV = W_ABOUT + SZ_SQ;
constexpr size_t W_COUT = W_CQKV + SZ_CQKV;
constexpr size_t W_MLPIN = W_COUT + SZ_SQ;
constexpr size_t W_MLPOUT = W_MLPIN + 2 * SZ_MLP;
constexpr size_t R1 = W_MLPOUT + 2 * SZ_MLP;
constexpr size_t SZ_R1 = (size_t)NTOK * DM * 2;
constexpr size_t R2 = R1 + SZ_R1;
constexpr size_t SZ_R2 = (size_t)NTOK * DFF * 2;
constexpr size_t R3 = R2 + SZ_R2;
constexpr size_t SM0 = R3 + SZ_R1;
constexpr size_t S_ADA = SM0;
constexpr size_t S_BAR = S_ADA + 2 * 5 * 12288 * 4;
constexpr size_t S_GATES = S_BAR + 8192;
constexpr size_t S_GC = S_GATES + (size_t)NTOK * 32 * 4;
constexpr size_t S_CKC = S_GC + (size_t)6144 * 64 * 4;
constexpr size_t S_CVTC = S_CKC + (size_t)4 * 4 * 256 * 64 * 2;
constexpr size_t S_CTR = S_CVTC + (size_t)4 * 4 * 256 * 64 * 2;
constexpr size_t WS_TOTAL = S_CTR + 1024;
constexpr size_t R2_PA = R2;
constexpr size_t R2_VTA = R2_PA + (size_t)NTOK * 2048 * 2;
constexpr size_t R2_PB = R2_VTA + (size_t)1024 * NTOK * 2;
constexpr size_t R2_PZ = R2_PB + (size_t)NTOK * 3072 * 2;
constexpr size_t R2_QK = R2_PZ + (size_t)NTOK * 1024 * 2;
constexpr size_t R2_QKC = R2;
constexpr size_t R2_VTC = R2_QKC + (size_t)NTOK * 2304 * 2;
constexpr size_t R1_QN = R1;
constexpr size_t R1_KNT = R1 + (size_t)NTOK * 1024 * 2;

struct Params { const float* in[27]; float* out; char* ws; };

DEV unsigned xcc_id() { return (unsigned)__builtin_amdgcn_s_getreg((3 << 11) | 20) & 7u; }
DEV void grid_barrier(unsigned* bar, unsigned k, unsigned n_here, unsigned n_xcc, unsigned xcc) {
    asm volatile("s_waitcnt vmcnt(0)" ::: "memory");
    __syncthreads();
    if (threadIdx.x < 64) {
        if (threadIdx.x == 0) {
            const unsigned old = __hip_atomic_fetch_add(bar + 64 * (8 + xcc), 1u, __ATOMIC_RELAXED, __HIP_MEMORY_SCOPE_AGENT);
            if (old + 1u == k * n_here) {
                __builtin_amdgcn_fence(__ATOMIC_RELEASE, "agent");
                asm volatile("s_waitcnt vmcnt(0)" ::: "memory");
                __hip_atomic_fetch_add(bar + 64 * 16, 1u, __ATOMIC_RELAXED, __HIP_MEMORY_SCOPE_AGENT);
            }
            unsigned spins = 0;
            while (__hip_atomic_load(bar + 64 * 16, __ATOMIC_RELAXED, __HIP_MEMORY_SCOPE_AGENT) < k * n_xcc && ++spins < (1u << 24)) __builtin_amdgcn_s_sleep(1);
        }
        __builtin_amdgcn_fence(__ATOMIC_ACQUIRE, "agent");
        asm volatile("s_waitcnt vmcnt(0)" ::: "memory");
    }
    __syncthreads();
}
DEV bf16_t f2bf(float f) { u32 u = __float_as_uint(f); u += 0x7fffu + ((u >> 16) & 1u); return (bf16_t)(u >> 16); }
DEV float bf2f(bf16_t h) { return __uint_as_float(((u32)h) << 16); }
typedef __bf16 bf16x2n __attribute__((ext_vector_type(2)));
DEV u32 pack2(float a, float b) { bf16x2n v; v[0] = (__bf16)a; v[1] = (__bf16)b; return __builtin_bit_cast(u32, v); }
DEV float bflo(u32 w) { return __uint_as_float(w << 16); }
DEV float bfhi(u32 w) { return __uint_as_float(w & 0xffff0000u); }
DEV f32x4 mfma16(bf16x8 a, bf16x8 b, f32x4 c) { return __builtin_amdgcn_mfma_f32_16x16x32_bf16(a, b, c, 0, 0, 0); }
DEV float siluf(float v) { return v / (1.f + __expf(-v)); }
DEV int cond_of(int row) { return row < NPR ? 0 : 1 + ((row - NPR) >> 12); }

DEV void ada_item(const Params& p, int item, char* smem) {
    const int tid = HTID;
    const int kq = item & 3, cb = (item >> 2) % 96, l = (item >> 2) / 96, n0 = cb * 128, kbase = kq * 512;
    float* sc = (float*)smem;
    BAR_LDS();
    for (int idx = tid; idx < 5 * 512; idx += NT) {
        const int ci = idx >> 9, k = kbase + (idx & 511);
        const float v = ci == 0 ? p.in[I_CCTX][k] : p.in[I_C][(ci - 1) * 2048 + k];
        sc[idx] = siluf(v);
    }
    BAR_LDS();
    const int cg4 = tid & 31, kg = tid >> 5;
    float acc[5][4];
#pragma unroll
    for (int ci = 0; ci < 5; ++ci) { acc[ci][0] = acc[ci][1] = acc[ci][2] = acc[ci][3] = 0.f; }
    const float* wp = p.in[I_WADA] + (size_t)l * 2048 * 12288 + (size_t)kbase * 12288 + n0 + 4 * cg4;
#pragma unroll 8
    for (int k = kg; k < 512; k += 8) {
        const float4 w = *(const float4*)(wp + (size_t)k * 12288);
#pragma unroll
        for (int ci = 0; ci < 5; ++ci) {
            const float sv = sc[ci * 512 + k];
            acc[ci][0] += sv * w.x; acc[ci][1] += sv * w.y; acc[ci][2] += sv * w.z; acc[ci][3] += sv * w.w;
        }
    }
    BAR_LDS();
    float* red = (float*)smem;
#pragma unroll
    for (int ci = 0; ci < 5; ++ci)
#pragma unroll
        for (int e = 0; e < 4; ++e) red[(kg * 5 + ci) * 128 + 4 * cg4 + e] = acc[ci][e];
    BAR_LDS();
    float* ada = (float*)(p.ws + S_ADA);
    for (int idx = tid; idx < 640; idx += NT) {
        const int ci = idx >> 7, c = idx & 127;
        float sum = (kq == 0) ? p.in[I_BADA][l * 12288 + n0 + c] : 0.f;
#pragma unroll
        for (int g = 0; g < 8; ++g) sum += red[(g * 5 + ci) * 128 + c];
        atomicAdd(ada + (size_t)(l * 5 + ci) * 12288 + n0 + c, sum);
    }
}

DEV void phase0(const Params& p, char* smem) {
    if (blockIdx.x == 0 && threadIdx.x < 128) ((int*)(p.ws + S_CTR))[threadIdx.x] = 0;
    for (int it = blockIdx.x * 2 + HALF_ID; it < 768; it += gridDim.x * 2) ada_item(p, it, smem);
    constexpr int T_ABIN = 16 * 116, T_SQ = 16 * 32, T_CQKV = 16 * 40, T_MLPIN = 16 * 128, T_MLPOUT = 64 * 32;
    constexpr int E1 = T_ABIN, E2 = E1 + T_SQ, E3 = E2 + T_CQKV, E4 = E3 + T_SQ, E5 = E4 + 2 * T_MLPIN, E6 = E5 + 2 * T_MLPOUT;
    static_assert((E6 & 1) == 0, "even tile count: both halves of a block run the same number of barriers");
    const int tid = HTID;
    float* T = (float*)smem;
    const float* src; bf16_t* dst; int K, N, kt, ntl;
#define TR_DECODE(t_) do { int t = (t_); \
        if (t < E1) { src = p.in[I_ABWI]; dst = (bf16_t*)(p.ws + W_ABIN); K = 2048; N = ABN; ntl = t % 116; kt = t / 116; } \
        else if (t < E2) { t -= E1; src = p.in[I_ABWO]; dst = (bf16_t*)(p.ws + W_ABOUT); K = 2048; N = 2048; ntl = t % 32; kt = t / 32; } \
        else if (t < E3) { t -= E2; src = p.in[I_CWQKV]; dst = (bf16_t*)(p.ws + W_CQKV); K = 2048; N = 2560; ntl = t % 40; kt = t / 40; } \
        else if (t < E4) { t -= E3; src = p.in[I_CWO]; dst = (bf16_t*)(p.ws + W_COUT); K = 2048; N = 2048; ntl = t % 32; kt = t / 32; } \
        else if (t < E5) { t -= E4; const int l = t / T_MLPIN; t -= l * T_MLPIN; src = p.in[I_WMI] + (size_t)l * 2048 * 8192; \
            dst = (bf16_t*)(p.ws + W_MLPIN + (size_t)l * SZ_MLP); K = 2048; N = 8192; ntl = t % 128; kt = t / 128; } \
        else { t -= E5; const int l = t / T_MLPOUT; t -= l * T_MLPOUT; src = p.in[I_WMO] + (size_t)l * 8192 * 2048; \
            dst = (bf16_t*)(p.ws + W_MLPOUT + (size_t)l * SZ_MLP); K = 8192; N = 2048; ntl = t % 32; kt = t / 32; } } while (0)
    float4 A0, A1, A2, A3, A4, A5, A6, A7, B0, B1, B2, B3, B4, B5, B6, B7;
    bf16_t* dA = nullptr; bf16_t* dB = nullptr; int KA = 0, KB = 0;
    const int lr = tid >> 4, lc = (tid & 15) * 4;
#define TR_LD1(rr, i_) do { const int n = ntl * 64 + lc; rr = make_float4(0.f, 0.f, 0.f, 0.f); \
        if (n < N) rr = *(const float4*)(src + (size_t)(kt * 128 + lr + 16 * (i_)) * N + n); } while (0)
#define TR_LOAD(S, t_) do { TR_DECODE(t_); TR_LD1(S##0, 0); TR_LD1(S##1, 1); TR_LD1(S##2, 2); TR_LD1(S##3, 3); TR_LD1(S##4, 4); TR_LD1(S##5, 5); TR_LD1(S##6, 6); TR_LD1(S##7, 7); \
        d##S = dst + (size_t)(ntl * 64) * K + kt * 128; K##S = K; } while (0)
#define TR_ST1(rr, i_) do { float* q = T + (lr + 16 * (i_)) * 65 + lc; q[0] = rr.x; q[1] = rr.y; q[2] = rr.z; q[3] = rr.w; } while (0)
#define TR_STEP(S) do { \
        BAR_LDS(); \
        TR_ST1(S##0, 0); TR_ST1(S##1, 1); TR_ST1(S##2, 2); TR_ST1(S##3, 3); TR_ST1(S##4, 4); TR_ST1(S##5, 5); TR_ST1(S##6, 6); TR_ST1(S##7, 7); \
        bf16_t* dcur = d##S; const int Kcur = K##S; \
        BAR_LDS(); \
        { const int tn = min(tcur + 2 * tstride, E6 - 1); TR_LOAD(S, tn); }        \
        _Pragma("unroll") for (int it = 0; it < 4; ++it) { \
            const int c = tid + 256 * it, n = c >> 4, kc = c & 15; \
            const float* t = T + (8 * kc) * 65 + n; \
            uint4 o; \
            o.x = pack2(t[0 * 65], t[1 * 65]); o.y = pack2(t[2 * 65], t[3 * 65]); \
            o.z = pack2(t[4 * 65], t[5 * 65]); o.w = pack2(t[6 * 65], t[7 * 65]); \
            *(uint4*)(dcur + (size_t)n * Kcur + 8 * kc) = o; } \
        tcur += tstride; } while (0)
    const int tstride = gridDim.x * 2;
    int tcur = blockIdx.x * 2 + HALF_ID;
    { const int t0 = min(tcur, E6 - 1); TR_LOAD(A, t0); const int t1 = min(tcur + tstride, E6 - 1); TR_LOAD(B, t1); }
    while (tcur < E6) {
        TR_STEP(A);
        if (tcur < E6) TR_STEP(B);
    }
#undef TR_STEP
#undef TR_DECODE
#undef TR_LD1
#undef TR_LOAD
#undef TR_ST1
    const int gtid = blockIdx.x * 512 + threadIdx.x, gstride = gridDim.x * 512;
    bf16_t* cKA = (bf16_t*)(p.out + O_CK);
    bf16_t* cVtA = cKA + (size_t)4 * 8 * 256 * 128;
    for (int idx = gtid; idx < 4 * 8 * 256 * 128; idx += gstride) {
        const int d = idx & 127, h = (idx >> 7) & 7, s = (idx >> 10) & 255, b = idx >> 18;
        cKA[((size_t)(b * 8 + h) * 256 + s) * 128 + d] = f2bf(p.in[I_CAK][idx]);
        cVtA[((size_t)(b * 8 + h) * 128 + d) * 256 + s] = f2bf(p.in[I_CAV][idx]);
    }
    bf16_t* cKC = (bf16_t*)(p.ws + S_CKC);
    bf16_t* cVtC = (bf16_t*)(p.ws + S_CVTC);
    for (int idx = gtid; idx < 4 * 4 * 256 * 64; idx += gstride) {
        const int d = idx & 63, h = (idx >> 6) & 3, s = (idx >> 8) & 255, b = idx >> 16;
        cKC[((size_t)(b * 4 + h) * 256 + s) * 64 + d] = f2bf(p.in[I_CCK][idx]);
        cVtC[((size_t)(b * 4 + h) * 64 + d) * 256 + s] = f2bf(p.in[I_CCV][idx]);
    }
}

template <bool INBF16>
DEV void modulate_phase(const float* __restrict__ x0, const float* __restrict__ x1, const bf16_t* __restrict__ xb, const float* __restrict__ g,
                        const float* __restrict__ ada_l, int shift_idx, bf16_t* __restrict__ hout) {
    int t_ = (int)threadIdx.x;
    asm volatile("" : "+v"(t_));
    const int lane = t_ & 63, wave = __builtin_amdgcn_readfirstlane(t_ >> 6);
    const int nw = gridDim.x * 8, rpw = (NTOK + nw - 1) / nw;
    const int rb = (blockIdx.x * 8 + wave) * rpw, re = min(NTOK, rb + rpw);
    if (rb >= re) return;
    float4 gp[8], sp[8];
    auto ldrow = [&](float4 (&v)[8], int row) __attribute__((always_inline)) {
        const float* xr = row < NPR ? x0 + (size_t)row * DM : x1 + (size_t)(row - NPR) * DM;
#pragma unroll
        for (int i = 0; i < 8; ++i) {
            if (INBF16) { const uint2 r = *(const uint2*)(xb + (size_t)row * DM + (i * 64 + lane) * 4); v[i] = make_float4(bflo(r.x), bfhi(r.x), bflo(r.y), bfhi(r.y)); }
            else v[i] = *(const float4*)(xr + (i * 64 + lane) * 4);
        }
    };
    float4 vn[8];
    ldrow(vn, rb);
    int row = rb;
#pragma unroll 1
    while (row < re) {
      const int cond = cond_of(row);
      const int seg_end = min(re, cond == 0 ? NPR : NPR + 4096 * cond);
      {
        const float* sh = ada_l + (size_t)cond * 12288 + shift_idx * 2048;
#pragma unroll
        for (int i = 0; i < 8; ++i) {
            const int c = (i * 64 + lane) * 4;
            const float4 gg = *(const float4*)(g + c), c4 = *(const float4*)(sh + 2048 + c);
            sp[i] = *(const float4*)(sh + c);
            gp[i] = make_float4(gg.x * (1.f + c4.x), gg.y * (1.f + c4.y), gg.z * (1.f + c4.z), gg.w * (1.f + c4.w));
        }
      }
#pragma unroll 1
      for (; row < seg_end; ++row) {
        float4 v[8];
#pragma unroll
        for (int i = 0; i < 8; ++i) v[i] = vn[i];
        ldrow(vn, min(row + 1, re - 1));
        float ss = 0.f;
#pragma unroll
        for (int i = 0; i < 8; ++i) ss += v[i].x * v[i].x + v[i].y * v[i].y + v[i].z * v[i].z + v[i].w * v[i].w;
#pragma unroll
        for (int o = 32; o >= 1; o >>= 1) ss += __shfl_xor(ss, o);
        const float rstd = rsqrtf(ss * (1.f / 2048.f) + 1e-6f);
#pragma unroll
        for (int i = 0; i < 8; ++i) {
            const int c = (i * 64 + lane) * 4;
            uint2 o;
            o.x = pack2(v[i].x * rstd * gp[i].x + sp[i].x, v[i].y * rstd * gp[i].y + sp[i].y);
            o.y = pack2(v[i].z * rstd * gp[i].z + sp[i].z, v[i].w * rstd * gp[i].w + sp[i].w);
            *(uint2*)(hout + (size_t)row * DM + c) = o;
        }
      }
    }
}

DEV void final_norm_phase(const bf16_t* __restrict__ xb, float* __restrict__ x, const float* __restrict__ g) {
    const int lane = threadIdx.x & 63, wave = threadIdx.x >> 6;
    for (int row = blockIdx.x * 8 + wave; row < NTOK; row += gridDim.x * 8) {
        float* xr = x + (size_t)row * DM;
        float4 v[8];
        float ss = 0.f;
#pragma unroll
        for (int i = 0; i < 8; ++i) {
            { const uint2 r = *(const uint2*)(xb + (size_t)row * DM + (i * 64 + lane) * 4); v[i] = make_float4(bflo(r.x), bfhi(r.x), bflo(r.y), bfhi(r.y)); }
            ss += v[i].x * v[i].x + v[i].y * v[i].y + v[i].z * v[i].z + v[i].w * v[i].w;
        }
#pragma unroll
        for (int o = 32; o >= 1; o >>= 1) ss += __shfl_xor(ss, o);
        const float rstd = rsqrtf(ss * (1.f / 2048.f) + 1e-6f);
#pragma unroll
        for (int i = 0; i < 8; ++i) {
            const int c = (i * 64 + lane) * 4;
            const float4 gg = *(const float4*)(g + c);
            float4 o;
            o.x = v[i].x * rstd * gg.x; o.y = v[i].y * rstd * gg.y; o.z = v[i].z * rstd * gg.z; o.w = v[i].w * rstd * gg.w;
            *(float4*)(xr + c) = o;
        }
    }
}

#define LAS __attribute__((address_space(3)))
namespace g8 {
constexpr int BM = 256, BK = 64, HALF = 128, HTB = HALF * BK * 2, NXCD = 8, WGM = 8;
DEV int lds_byte(int r, int c) { const int st = (r >> 4) * 2 + (c >> 5), rr = r & 15, cc = c & 31, ob = rr * 64 + cc * 2; return st * 1024 + (ob ^ (((ob >> 9) & 1) << 5)); }
DEV void stage_rc(int b, int& R, int& C) { const int st = b / 1024, sb = b % 1024, swz = sb ^ (((sb >> 9) & 1) << 5); R = (st >> 1) * 16 + swz / 64; C = (st & 1) * 32 + (swz % 64) / 2; }
DEV int perm32(int rho) { const int n = rho >> 4, i = rho & 15; return 8 * (i >> 2) + 4 * n + (i & 3); }
struct Unit { int pm, pn; };
struct Order {
    int nM, nN, nwg, G, c;
    DEV void init(int M, int N, int G_, int c_) { nM = M / BM; nN = N / BM; nwg = nM * nN; G = G_; c = c_; }
    DEV bool next(int i, Unit& u) const {
        const long L = (long)i * G + c; if (L >= nwg) return false;
        int wgid = (int)L; { const int q = nwg / NXCD, r = nwg % NXCD, xcd = wgid % NXCD, off = wgid / NXCD; wgid = (xcd < r ? xcd * (q + 1) : r * (q + 1) + (xcd - r) * q) + off; }
        const int nig = WGM * nN, gid = wgid / nig, fm = gid * WGM, gsz = (nM - fm) < WGM ? (nM - fm) : WGM;
        u.pm = fm + ((wgid % nig) % gsz); u.pn = (wgid % nig) / gsz; return true;
    }
};
typedef f32x4 Acc[2][2][4][2];

template <class Epi>
DEV void gemm_phase(LAS unsigned char* lds, const bf16_t* __restrict__ A, const bf16_t* __restrict__ Bt, int M, int N, int K, const Epi& E) {
    int tid = threadIdx.x;
    asm volatile("" : "+v"(tid));
    const int wid = __builtin_amdgcn_readfirstlane(tid >> 6), lane = tid & 63, wr = wid >> 2, wc = wid & 3, fr = lane & 15, fq = lane >> 4;
    const int nt = K / BK;
    Order S; S.init(M, N, (int)gridDim.x, (int)blockIdx.x);
    unsigned voffA[2], voffB[2];
#pragma unroll
    for (int i = 0; i < 2; ++i) { int R, C; stage_rc(tid * 16 + i * 8192, R, C); const int Rb = Epi::PERM ? ((R & ~31) + perm32(R & 31)) : R;
        voffA[i] = (unsigned)(R * K + C) * 2u; voffB[i] = (unsigned)(Rb * K + C) * 2u; }
    const size_t kstep = (size_t)(BK * 2);
    const size_t hstep = (size_t)HALF * K * 2;
    const size_t tstep = 2 * hstep;
    const unsigned ldsw = (unsigned)wid * 1024u;
    const int aoff = lds_byte(wr * 64 + fr, fq * 8), boff = lds_byte(wc * 32 + fr, fq * 8);
#define G8_SA(b, h) (((b) * 2 + (h)) * HTB)
#define G8_SB(b, h) ((4 + (b) * 2 + (h)) * HTB)
#define G8_STAGE_(bufoff, gbase, voff) do { _Pragma("unroll") for (int _i = 0; _i < 2; ++_i) \
        __builtin_amdgcn_global_load_lds((const unsigned*)((const char*)(gbase) + (voff)[_i]), (LAS unsigned*)(lds + (bufoff) + ldsw + _i * 8192), 16, 0, 0); } while (0)
#define G8_STAGE(bufoff, gbase) G8_STAGE_(bufoff, gbase, voffA)
#define G8_STAGEB(bufoff, gbase) G8_STAGE_(bufoff, gbase, voffB)
#define G8_LDA(dst, b, h) do { _Pragma("unroll") for (int m = 0; m < 4; ++m) _Pragma("unroll") for (int k = 0; k < 2; ++k) dst[m][k] = *(const LAS bf16x8*)(lds + G8_SA(b, h) + aoff + m * 2048 + k * 1024); } while (0)
#define G8_LDB(dst, b, h) do { _Pragma("unroll") for (int n = 0; n < 2; ++n) _Pragma("unroll") for (int k = 0; k < 2; ++k) dst[n][k] = *(const LAS bf16x8*)(lds + G8_SB(b, h) + boff + n * 2048 + k * 1024); } while (0)
#define G8_MMA(ai, bj, At, Bt_) do { __builtin_amdgcn_s_setprio(1); _Pragma("unroll") for (int m = 0; m < 4; ++m) _Pragma("unroll") for (int n = 0; n < 2; ++n) _Pragma("unroll") for (int k = 0; k < 2; ++k) \
        acc[ai][bj][m][n] = __builtin_amdgcn_mfma_f32_16x16x32_bf16(Bt_[n][k], At[m][k], acc[ai][bj][m][n], 0, 0, 0); __builtin_amdgcn_s_setprio(0); } while (0)
#define G8_WAIT_V(n) asm volatile("s_waitcnt vmcnt(" #n ")" ::: "memory")
#define G8_WAIT_L(n) asm volatile("s_waitcnt lgkmcnt(" #n ")" ::: "memory")
#define G8_BAR __builtin_amdgcn_s_barrier()
#define G8_SCHED __builtin_amdgcn_sched_barrier(0)
    Unit cur, nxt; int ui = 0;
    if (!S.next(0, cur)) return;
    Acc acc;
#pragma unroll
    for (int a = 0; a < 2; ++a)
#pragma unroll
        for (int b = 0; b < 2; ++b)
#pragma unroll
            for (int m = 0; m < 4; ++m)
#pragma unroll
                for (int n = 0; n < 2; ++n) acc[a][b][m][n] = (f32x4){0.f, 0.f, 0.f, 0.f};
    bf16x8 At[4][2], B0[2][2], B1[2][2];
    const char* cA = (const char*)A + (size_t)cur.pm * tstep; const char* cB = (const char*)Bt + (size_t)cur.pn * tstep;
    G8_STAGEB(G8_SB(0, 0), cB); G8_STAGE(G8_SA(0, 0), cA); G8_STAGEB(G8_SB(0, 1), cB + hstep); G8_STAGE(G8_SA(0, 1), cA + hstep);
    if (wr == 1) G8_BAR;
    G8_WAIT_V(4); G8_BAR;
    G8_STAGEB(G8_SB(1, 0), cB + kstep); G8_STAGE(G8_SA(1, 0), cA + kstep); G8_STAGEB(G8_SB(1, 1), cB + hstep + kstep);
    G8_WAIT_V(6); G8_BAR;
    for (;;) {
        const bool has_next = S.next(ui + 1, nxt);
        const char* nA = has_next ? (const char*)A + (size_t)nxt.pm * tstep : cA; const char* nB = has_next ? (const char*)Bt + (size_t)nxt.pn * tstep : cB;
        for (int t = 0; t < nt; t += 2) {
            const bool last = (t == nt - 2);
            const char* a1 = cA + (size_t)(t + 1) * kstep;
            const char* a2 = last ? nA : cA + (size_t)(t + 2) * kstep; const char* b2 = last ? nB : cB + (size_t)(t + 2) * kstep;
            const char* a3 = a2 + kstep; const char* b3 = b2 + kstep;
            G8_LDB(B0, 0, 0); G8_SCHED; G8_LDA(At, 0, 0); G8_STAGE(G8_SA(1, 1), a1 + hstep);
            G8_WAIT_L(8); G8_BAR; G8_WAIT_L(0); G8_MMA(0, 0, At, B0); G8_BAR; G8_SCHED;
            G8_LDB(B1, 0, 1); G8_STAGEB(G8_SB(0, 0), b2);
            G8_BAR; G8_WAIT_L(0); G8_MMA(0, 1, At, B1); G8_BAR;
            G8_LDA(At, 0, 1); G8_STAGE(G8_SA(0, 0), a2);
            G8_BAR; G8_WAIT_L(0); G8_MMA(1, 0, At, B0); G8_BAR; G8_SCHED;
            G8_STAGEB(G8_SB(0, 1), b2 + hstep);
            G8_WAIT_V(6); G8_BAR; G8_MMA(1, 1, At, B1); G8_BAR;
            G8_LDB(B0, 1, 0); G8_SCHED; G8_LDA(At, 1, 0); G8_STAGE(G8_SA(0, 1), a2 + hstep);
            G8_WAIT_L(8); G8_BAR; G8_WAIT_L(0); G8_MMA(0, 0, At, B0); G8_BAR; G8_SCHED;
            G8_LDB(B1, 1, 1); G8_STAGEB(G8_SB(1, 0), b3);
            G8_BAR; G8_WAIT_L(0); G8_MMA(0, 1, At, B1); G8_BAR;
            G8_LDA(At, 1, 1); G8_STAGE(G8_SA(1, 0), a3);
            G8_BAR; G8_WAIT_L(0); G8_MMA(1, 0, At, B0); G8_BAR; G8_SCHED;
            G8_STAGEB(G8_SB(1, 1), b3 + hstep);
            G8_WAIT_V(6); G8_BAR; G8_MMA(1, 1, At, B1); G8_BAR;
        }
        E(acc, cur, wr, wc, fr, fq);
        if (!has_next) break;
#pragma unroll
        for (int a = 0; a < 2; ++a)
#pragma unroll
            for (int b = 0; b < 2; ++b)
#pragma unroll
                for (int m = 0; m < 4; ++m)
#pragma unroll
                    for (int n = 0; n < 2; ++n) acc[a][b][m][n] = (f32x4){0.f, 0.f, 0.f, 0.f};
        cur = nxt; cA = nA; cB = nB; ++ui;
    }
    G8_WAIT_V(0);
    if (wr == 0) G8_BAR;
    G8_BAR;
#undef G8_SA
#undef G8_SB
#undef G8_STAGE
#undef G8_STAGEB
#undef G8_STAGE_
#undef G8_LDA
#undef G8_LDB
#undef G8_MMA
#undef G8_WAIT_V
#undef G8_WAIT_L
#undef G8_BAR
#undef G8_SCHED
}
}

#define EPI_LOOP_ROWS for (int ai = 0; ai < 2; ++ai) _Pragma("unroll") for (int m = 0; m < 4; ++m)
#define EPI_LOOP_COLS for (int bj = 0; bj < 2; ++bj) _Pragma("unroll") for (int n = 0; n < 2; ++n)
struct EpiProj0 {
    static constexpr bool PERM = true;
    bf16_t* PA; bf16_t* VtA; bf16_t* PB; bf16_t* PZ; float* gates; float* nak; float* nav;
    DEV void operator()(const g8::Acc& acc, const g8::Unit& u, int wr, int wc, int fr, int fq) const {
        const int colt = u.pn * 256 + wc * 32 + 8 * fq;
#pragma unroll
        EPI_LOOP_ROWS {
            const int row = u.pm * 256 + ai * 128 + wr * 64 + m * 16 + fr;
#pragma unroll
            for (int bj = 0; bj < 2; ++bj) {
                const int col = colt + bj * 128;
                const f32x4 v0 = acc[ai][bj][m][0], v1 = acc[ai][bj][m][1];
                uint4 o; o.x = pack2(v0[0], v0[1]); o.y = pack2(v0[2], v0[3]); o.z = pack2(v1[0], v1[1]); o.w = pack2(v1[2], v1[3]);
                if (col < 2048) {
                    *(uint4*)(PA + (size_t)row * 2048 + col) = o;
                    if (col >= 1024 && row < NPR) { float* d = nak + (size_t)row * 1024 + (col - 1024); *(f32x4*)d = v0; *(f32x4*)(d + 4) = v1; }
                } else if (col < 3072) {
#pragma unroll
                    for (int j = 0; j < 4; ++j) { VtA[(size_t)(col - 2048 + j) * NTOK + row] = f2bf(v0[j]); VtA[(size_t)(col - 2048 + 4 + j) * NTOK + row] = f2bf(v1[j]); }
                    if (row < NPR) { float* d = nav + (size_t)row * 1024 + (col - 2048); *(f32x4*)d = v0; *(f32x4*)(d + 4) = v1; }
                } else if (col < 6144) {
                    *(uint4*)(PB + (size_t)row * 3072 + (col - 3072)) = o;
                } else if (col < 7168) {
                    *(uint4*)(PZ + (size_t)row * 1024 + (col - 6144)) = o;
                } else if (col < ABN) {
                    float* d = gates + (size_t)row * 32 + (col - 7168); *(f32x4*)d = v0; *(f32x4*)(d + 4) = v1;
                }
            }
        }
    }
};
template <bool INF32>
struct EpiRes {
    static constexpr bool PERM = true;
    const float* xin0; const float* xin1; const bf16_t* xbin; bf16_t* xbout; const float* gate;
    DEV void operator()(const g8::Acc& acc, const g8::Unit& u, int wr, int wc, int fr, int fq) const {
        const int colt = u.pn * 256 + wc * 32 + 8 * fq;
#pragma unroll
        EPI_LOOP_ROWS {
            const int row = u.pm * 256 + ai * 128 + wr * 64 + m * 16 + fr;
            const float* xr = row < NPR ? xin0 + (size_t)row * DM : xin1 + (size_t)(row - NPR) * DM;
            const float* gr = gate + (size_t)cond_of(row) * 12288;
#pragma unroll
            for (int bj = 0; bj < 2; ++bj) {
                const int col = colt + bj * 128;
                f32x4 x0, x1;
                if (INF32) { x0 = *(const f32x4*)(xr + col); x1 = *(const f32x4*)(xr + col + 4); }
                else { const uint4 r = *(const uint4*)(xbin + (size_t)row * DM + col);
                    x0 = (f32x4){bflo(r.x), bfhi(r.x), bflo(r.y), bfhi(r.y)}; x1 = (f32x4){bflo(r.z), bfhi(r.z), bflo(r.w), bfhi(r.w)}; }
                const f32x4 g0 = *(const f32x4*)(gr + col), g1 = *(const f32x4*)(gr + col + 4);
                const f32x4 r0 = x0 + g0 * acc[ai][bj][m][0], r1 = x1 + g1 * acc[ai][bj][m][1];
                uint4 o; o.x = pack2(r0[0], r0[1]); o.y = pack2(r0[2], r0[3]); o.z = pack2(r1[0], r1[1]); o.w = pack2(r1[2], r1[3]);
                *(uint4*)(xbout + (size_t)row * DM + col) = o;
            }
        }
    }
};
struct EpiMlp1 {
    static constexpr bool PERM = true;
    bf16_t* H;
    DEV void operator()(const g8::Acc& acc, const g8::Unit& u, int wr, int wc, int fr, int fq) const {
        const int colt = u.pn * 256 + wc * 32 + 8 * fq;
#pragma unroll
        EPI_LOOP_ROWS {
            const int row = u.pm * 256 + ai * 128 + wr * 64 + m * 16 + fr;
#pragma unroll
            for (int bj = 0; bj < 2; ++bj) {
                f32x4 v0 = acc[ai][bj][m][0], v1 = acc[ai][bj][m][1];
#pragma unroll
                for (int j = 0; j < 4; ++j) { const float r0 = fmaxf(v0[j], 0.f), r1 = fmaxf(v1[j], 0.f); v0[j] = r0 * r0; v1[j] = r1 * r1; }
                uint4 o; o.x = pack2(v0[0], v0[1]); o.y = pack2(v0[2], v0[3]); o.z = pack2(v1[0], v1[1]); o.w = pack2(v1[2], v1[3]);
                *(uint4*)(H + (size_t)row * DFF + colt + bj * 128) = o;
            }
        }
    }
};
struct EpiQkv1 {
    static constexpr bool PERM = false;
    bf16_t* QK; bf16_t* VtC; float* nck; float* ncv;
    DEV void operator()(const g8::Acc& acc, const g8::Unit& u, int wr, int wc, int fr, int fq) const {
        float inv[4];
#pragma unroll
        for (int j = 0; j < 4; ++j) inv[j] = exp2f(-(float)(fq * 4 + j) * 0.830482023721841f) * 0.15915494309189535f;
#pragma unroll
        EPI_LOOP_ROWS {
            const int row = u.pm * 256 + ai * 128 + wr * 64 + m * 16 + fr;
            const bool sample = row >= NPR;
            const int tok = (row - NPR) & 4095;
            const float pos = (float)((wc & 1) ? (tok & 63) : (tok >> 6));
#pragma unroll
            for (int bj = 0; bj < 2; ++bj) {
                const int cb = u.pn * 256 + bj * 128 + wc * 32 + 4 * fq;
                const f32x4 v0 = acc[ai][bj][m][0], v1 = acc[ai][bj][m][1];
                if (cb < 2304) {
                    if (!sample && cb >= 2048) {
                        *(f32x4*)(nck + (size_t)row * 256 + (cb - 2048)) = v0;
                        *(f32x4*)(nck + (size_t)row * 256 + (cb - 2048) + 16) = v1;
                    }
                    f32x4 o0 = v0, o1 = v1;
                    if (sample) {
#pragma unroll
                        for (int j = 0; j < 4; ++j) {
                            float rev = pos * inv[j];
                            rev -= floorf(rev);
                            const float sn = __builtin_amdgcn_sinf(rev), cs = __builtin_amdgcn_cosf(rev);
                            o0[j] = v0[j] * cs - v1[j] * sn;
                            o1[j] = v1[j] * cs + v0[j] * sn;
                        }
                    }
                    uint2 w0, w1; w0.x = pack2(o0[0], o0[1]); w0.y = pack2(o0[2], o0[3]); w1.x = pack2(o1[0], o1[1]); w1.y = pack2(o1[2], o1[3]);
                    *(uint2*)(QK + (size_t)row * 2304 + cb) = w0;
                    *(uint2*)(QK + (size_t)row * 2304 + cb + 16) = w1;
                } else {
                    const int c = cb - 2304;
#pragma unroll
                    for (int j = 0; j < 4; ++j) { VtC[(size_t)(c + j) * NTOK + row] = f2bf(v0[j]); VtC[(size_t)(c + 16 + j) * NTOK + row] = f2bf(v1[j]); }
                    if (!sample) { *(f32x4*)(ncv + (size_t)row * 256 + c) = v0; *(f32x4*)(ncv + (size_t)row * 256 + c + 16) = v1; }
                }
            }
        }
    }
};

template <int MODE>
DEV void attn_item(const Params& p, int item, char* smem) {
    constexpr int HD = (MODE <= 1) ? 128 : 64;
    constexpr int KST = HD + 8;
    constexpr int NKS = HD / 32, ND = HD / 16;
    constexpr int NH = (MODE <= 1) ? 1 : 2;
    constexpr int NR = (HD == 128) ? 4 : 2;
    constexpr int KCH = HD / 8;
    bf16_t* Ks = (bf16_t*)smem;
    bf16_t* Vt = Ks + 64 * KST;
    bf16_t* Ps = Vt + HD * 72;
    float* bias_s = (float*)(Ps + 4 * 16 * 72);
    const int tid = HTID, lane = tid & 63, w = tid >> 6, fr = lane & 15, fq = lane >> 4;
    const float scale = (MODE <= 1) ? 0.08838834764831845f : 0.125f;

    const bf16_t* PA = (const bf16_t*)(p.ws + R2_PA);
    const bf16_t* VtA = (const bf16_t*)(p.ws + R2_VTA);
    const bf16_t* QKC = (const bf16_t*)(p.ws + R2_QKC);
    const bf16_t* VtC = (const bf16_t*)(p.ws + R2_VTC);
    bf16_t* O = (bf16_t*)(p.ws + R3);

    int b, h, qt, qrow0, ntot, rs = 0, r = 0, kvh = 0, kt0 = 0, nloc = 0;
    const bf16_t* qptr; int qstride;
    bf16_t* optr;
    if (MODE == 0) {
        qt = item & 3; h = (item >> 2) & 7; b = item >> 5;
        qrow0 = b * 256 + qt * 64; qptr = PA + (size_t)qrow0 * 2048 + h * 128; qstride = 2048; ntot = 4;
        optr = O + (size_t)qrow0 * 2048 + h * 128;
    } else if (MODE == 1) {
        r = item & 63; h = (item >> 6) & 7; b = item >> 9; qt = r;
        qrow0 = NPR + b * 4096 + r * 64; qptr = PA + (size_t)qrow0 * 2048 + h * 128; qstride = 2048; ntot = 12; nloc = 8;
        rs = min(max(r - 4, 0), 56);
        optr = O + (size_t)qrow0 * 2048 + h * 128;
    } else if (MODE == 2) {
        qt = item & 3; const int hg = (item >> 2) & 15; b = item >> 6; h = hg * 2; kvh = hg >> 2;
        qrow0 = b * 256 + qt * 64; qptr = QKC + (size_t)qrow0 * 2304 + h * 64; qstride = 2304; ntot = 4;
        optr = O + (size_t)qrow0 * 2048 + h * 64;
    } else {
        qt = (item >> 1) & 63; const int hg = ((item >> 7) & 7) * 2 + (item & 1); b = item >> 10; h = hg * 2; kvh = hg >> 2;
        qrow0 = NPR + b * 4096 + qt * 64; qptr = QKC + (size_t)qrow0 * 2304 + h * 64; qstride = 2304;
        kt0 = max(qt - 2, 0); nloc = min(qt + 2, 63) - kt0 + 1; ntot = nloc + 4;
        optr = O + (size_t)qrow0 * 2048 + h * 64;
    }

    const bf16_t* kptr; const bf16_t* vptr; int kstride, vstride;
#define AT_PTRS(n) do { \
        if (MODE == 0) { const int krow0 = b * 256 + (n) * 64; \
            kptr = PA + (size_t)krow0 * 2048 + 1024 + h * 128; kstride = 2048; vptr = VtA + (size_t)(h * 128) * NTOK + krow0; vstride = NTOK; } \
        else if (MODE == 1) { \
            if ((n) < 8) { const int krow0 = NPR + b * 4096 + (rs + (n)) * 64; \
                kptr = PA + (size_t)krow0 * 2048 + 1024 + h * 128; kstride = 2048; vptr = VtA + (size_t)(h * 128) * NTOK + krow0; vstride = NTOK; } \
            else { const bf16_t* cKA = (const bf16_t*)(p.out + O_CK); const bf16_t* cVtA = cKA + (size_t)4 * 8 * 256 * 128; \
                kptr = cKA + ((size_t)(b * 8 + h) * 256 + ((n) - 8) * 64) * 128; kstride = 128; \
                vptr = cVtA + (size_t)(b * 8 + h) * 128 * 256 + ((n) - 8) * 64; vstride = 256; } } \
        else if (MODE == 2) { const int krow0 = b * 256 + (n) * 64; \
            kptr = QKC + (size_t)krow0 * 2304 + 2048 + kvh * 64; kstride = 2304; vptr = VtC + (size_t)(kvh * 64) * NTOK + krow0; vstride = NTOK; } \
        else { \
            if ((n) < nloc) { const int krow0 = NPR + b * 4096 + (kt0 + (n)) * 64; \
                kptr = QKC + (size_t)krow0 * 2304 + 2048 + kvh * 64; kstride = 2304; vptr = VtC + (size_t)(kvh * 64) * NTOK + krow0; vstride = NTOK; } \
            else { const bf16_t* cKC = (const bf16_t*)(p.ws + S_CKC); const bf16_t* cVtC = (const bf16_t*)(p.ws + S_CVTC); \
                kptr = cKC + ((size_t)(b * 4 + kvh) * 256 + ((n) - nloc) * 64) * 64; kstride = 64; \
                vptr = cVtC + (size_t)(b * 4 + kvh) * 64 * 256 + ((n) - nloc) * 64; vstride = 256; } } \
    } while (0)
    const int krow = tid / KCH, kch = tid % KCH;
    const int vrow = tid >> 3, vch = tid & 7;
    uint4 kr0, kr1, kr2, kr3, vr0, vr1, vr2, vr3;
    kr2 = kr3 = vr2 = vr3 = make_uint4(0, 0, 0, 0);
#define AT_LOAD(n) do { AT_PTRS(n); \
        kr0 = *(const uint4*)(kptr + (size_t)krow * kstride + kch * 8); kr1 = *(const uint4*)(kptr + (size_t)(krow + 256 / KCH) * kstride + kch * 8); \
        vr0 = *(const uint4*)(vptr + (size_t)vrow * vstride + vch * 8); vr1 = *(const uint4*)(vptr + (size_t)(vrow + 32) * vstride + vch * 8); \
        if (NR == 4) { kr2 = *(const uint4*)(kptr + (size_t)(krow + 2 * (256 / KCH)) * kstride + kch * 8); kr3 = *(const uint4*)(kptr + (size_t)(krow + 3 * (256 / KCH)) * kstride + kch * 8); \
                       vr2 = *(const uint4*)(vptr + (size_t)(vrow + 64) * vstride + vch * 8); vr3 = *(const uint4*)(vptr + (size_t)(vrow + 96) * vstride + vch * 8); } \
    } while (0)
#define AT_STORE() do { \
        *(uint4*)(Ks + krow * KST + kch * 8) = kr0; *(uint4*)(Ks + (krow + 256 / KCH) * KST + kch * 8) = kr1; \
        *(uint4*)(Vt + vrow * 72 + vch * 8) = vr0; *(uint4*)(Vt + (vrow + 32) * 72 + vch * 8) = vr1; \
        if (NR == 4) { *(uint4*)(Ks + (krow + 2 * (256 / KCH)) * KST + kch * 8) = kr2; *(uint4*)(Ks + (krow + 3 * (256 / KCH)) * KST + kch * 8) = kr3; \
                       *(uint4*)(Vt + (vrow + 64) * 72 + vch * 8) = vr2; *(uint4*)(Vt + (vrow + 96) * 72 + vch * 8) = vr3; } \
    } while (0)

    AT_LOAD(0);
    constexpr float LOG2E = 1.4426950408889634f;
    const float c1 = scale * LOG2E;
    bf16x8 qf[NH][NKS];
    float mrow[NH], lpart[NH];
    f32x4 oacc[NH][ND];
#pragma unroll
    for (int hh = 0; hh < NH; ++hh) {
#pragma unroll
        for (int ks = 0; ks < NKS; ++ks) qf[hh][ks] = *(const bf16x8*)(qptr + (size_t)(16 * w + fr) * qstride + hh * 64 + ks * 32 + fq * 8);
        mrow[hh] = (MODE >= 2) ? p.in[I_SINK][h + hh] * LOG2E : -1e30f;
        lpart[hh] = (MODE >= 2 && fq == 0) ? 1.f : 0.f;
#pragma unroll
        for (int nd = 0; nd < ND; ++nd) oacc[hh][nd] = (f32x4){0.f, 0.f, 0.f, 0.f};
    }
    BAR_LDS();
    if (MODE == 1) { for (int i = tid; i < 465; i += 256) bias_s[i] = p.in[I_RELB][h * 465 + i] * LOG2E; }
    const int qi = 16 * w + fr;

#pragma unroll 1
    for (int n = 0; n < ntot; ++n) {
        if (n) BAR_LDS();
        AT_STORE();
        BAR_LDS();
        { const int nn = min(n + 1, ntot - 1); AT_LOAD(nn); }
        const bool local = n < nloc;
        const int dkt = (MODE == 3) ? (kt0 + n - qt) : 0;
#pragma unroll
        for (int hh = 0; hh < NH; ++hh) {
            f32x4 sacc[4];
#pragma unroll
            for (int nb = 0; nb < 4; ++nb) sacc[nb] = (f32x4){0.f, 0.f, 0.f, 0.f};
#pragma unroll
            for (int ks = 0; ks < NKS; ++ks)
#pragma unroll
                for (int nb = 0; nb < 4; ++nb) {
                    const bf16x8 kf = *(const bf16x8*)(Ks + (nb * 16 + fr) * KST + ks * 32 + fq * 8);
                    sacc[nb] = mfma16(kf, qf[hh][ks], sacc[nb]);
                }
            if (MODE == 1 && local) {
                const int cs = min(max(qi - 8, 0), 48);
                const float* brow = bias_s + (rs + n - r + 7) * 31 + 15 - qi;
#pragma unroll
                for (int nb = 0; nb < 4; ++nb)
#pragma unroll
                    for (int j = 0; j < 4; ++j) {
                        const int kj = nb * 16 + 4 * fq + j;
                        const bool ok = kj >= cs && kj < cs + 16;
                        sacc[nb][j] = ok ? sacc[nb][j] * c1 + brow[ok ? kj : qi] : -1e30f;
                    }
            } else if (MODE == 3 && local && (dkt == 2 || dkt == -2)) {
#pragma unroll
                for (int nb = 0; nb < 4; ++nb)
#pragma unroll
                    for (int j = 0; j < 4; ++j) {
                        const int dlt = dkt * 64 + nb * 16 + 4 * fq + j - qi;
                        sacc[nb][j] = (dlt > 128 || dlt < -128) ? -1e30f : sacc[nb][j] * c1;
                    }
            } else {
#pragma unroll
                for (int nb = 0; nb < 4; ++nb)
#pragma unroll
                    for (int j = 0; j < 4; ++j) sacc[nb][j] *= c1;
            }
            float mx = sacc[0][0];
#pragma unroll
            for (int nb = 0; nb < 4; ++nb)
#pragma unroll
                for (int j = 0; j < 4; ++j) mx = fmaxf(mx, sacc[nb][j]);
            mx = fmaxf(mx, __shfl_xor(mx, 16));
            mx = fmaxf(mx, __shfl_xor(mx, 32));
            const float mnew = fmaxf(mrow[hh], mx);
            const float alpha = __builtin_amdgcn_exp2f(mrow[hh] - mnew);
            mrow[hh] = mnew;
            float psum = 0.f;
#pragma unroll
            for (int nb = 0; nb < 4; ++nb)
#pragma unroll
                for (int j = 0; j < 4; ++j) { const float pv = __builtin_amdgcn_exp2f(sacc[nb][j] - mnew); sacc[nb][j] = pv; psum += pv; }
            lpart[hh] = lpart[hh] * alpha + psum;
#pragma unroll
            for (int nd = 0; nd < ND; ++nd)
#pragma unroll
                for (int j = 0; j < 4; ++j) oacc[hh][nd][j] *= alpha;
#pragma unroll
            for (int ks = 0; ks < 2; ++ks) {
                union { u32 u[4]; bf16x8 v; } pf;
                pf.u[0] = pack2(sacc[2 * ks][0], sacc[2 * ks][1]); pf.u[1] = pack2(sacc[2 * ks][2], sacc[2 * ks][3]);
                pf.u[2] = pack2(sacc[2 * ks + 1][0], sacc[2 * ks + 1][1]); pf.u[3] = pack2(sacc[2 * ks + 1][2], sacc[2 * ks + 1][3]);
#pragma unroll
                for (int nd = 0; nd < ND; ++nd) {
                    union { uint2 h2[2]; bf16x8 v; } vf;
                    vf.h2[0] = *(const uint2*)(Vt + (nd * 16 + fr) * 72 + ks * 32 + 4 * fq);
                    vf.h2[1] = *(const uint2*)(Vt + (nd * 16 + fr) * 72 + ks * 32 + 16 + 4 * fq);
                    oacc[hh][nd] = mfma16(vf.v, pf.v, oacc[hh][nd]);
                }
            }
        }
    }
#pragma unroll
    for (int hh = 0; hh < NH; ++hh) {
        float l = lpart[hh];
        l += __shfl_xor(l, 16);
        l += __shfl_xor(l, 32);
        const float linv = 1.f / l;
#pragma unroll
        for (int nd = 0; nd < ND; ++nd) {
            uint2 o;
            o.x = pack2(oacc[hh][nd][0] * linv, oacc[hh][nd][1] * linv);
            o.y = pack2(oacc[hh][nd][2] * linv, oacc[hh][nd][3] * linv);
            *(uint2*)(optr + (size_t)(16 * w + fr) * 2048 + hh * 64 + nd * 16 + 4 * fq) = o;
        }
    }
#undef AT_PTRS
#undef AT_LOAD
#undef AT_STORE
}

DEV void dn_prep_item(const Params& p, int item, char* smem) {
    const int tid = HTID, lane = tid & 63, w = tid >> 6, fr = lane & 15, fq = lane >> 4;
    const int cidx = item >> 3, h = item & 7;
    const int row0 = cidx * 64;
    int seq_start, seq_end;
    if (row0 < NPR) { seq_start = row0 & ~255; seq_end = seq_start + 256; }
    else { seq_start = NPR + ((row0 - NPR) & ~4095); seq_end = seq_start + 4096; }
    bf16_t* qs = (bf16_t*)smem;
    bf16_t* ks = qs + 64 * 136;
    bf16_t* vs = ks + 64 * 136;
    float* Ms = (float*)smem;
    float* sm_beta = (float*)(smem + 3 * 17408);
    float* sm_gc = sm_beta + 128;
    float* sm_su = sm_gc + 128;
    float* sm_sw = sm_su + 128;
    const bf16_t* PB = (const bf16_t*)(p.ws + R2_PB);
    const float* gates = (const float*)(p.ws + S_GATES);
    bf16_t* QN = (bf16_t*)(p.ws + R1_QN);
    bf16_t* KNT = (bf16_t*)(p.ws + R1_KNT);
    bf16_t* UT = (bf16_t*)(p.out);
    bf16_t* Wb = UT + (size_t)6144 * 128 * 64;
    bf16_t* QKb = (bf16_t*)(p.ws + R2_QK);
    float* GC = (float*)(p.ws + S_GC);
    const float* conv = p.in[I_CONV];

    BAR_LDS();
    {
        const int i = tid >> 2, dq = tid & 3;
        const int row = row0 + i;
        const bool hasPrev = (row - 1) >= seq_start, hasNext = (row + 1) < seq_end;
        const int offPrev = hasPrev ? -3072 : 0, offNext = hasNext ? 3072 : 0;
        auto ldpart = [&](uint4 (&x)[3][4], int part) __attribute__((always_inline)) {
            const bf16_t* px = PB + (size_t)row * 3072 + part * 1024 + h * 128 + dq * 32;
#pragma unroll
            for (int c8 = 0; c8 < 4; ++c8) {
                x[1][c8] = *(const uint4*)(px + c8 * 8);
                x[0][c8] = *(const uint4*)(px + c8 * 8 + offPrev);
                x[2][c8] = *(const uint4*)(px + c8 * 8 + offNext);
            }
        };
        auto do_part = [&](const uint4 (&x)[3][4], int part) __attribute__((always_inline)) {
            const int colbase = part * 1024 + h * 128 + dq * 32;
            float y[32];
            float ss = 0.f;
#pragma unroll
            for (int c8 = 0; c8 < 4; ++c8) {
                const uint4 x1 = x[1][c8];
                const uint4 x0 = hasPrev ? x[0][c8] : make_uint4(0, 0, 0, 0), x2 = hasNext ? x[2][c8] : make_uint4(0, 0, 0, 0);
                const float* wq = conv + colbase + c8 * 8;
                const u32 a0[4] = {x0.x, x0.y, x0.z, x0.w}, a1[4] = {x1.x, x1.y, x1.z, x1.w}, a2[4] = {x2.x, x2.y, x2.z, x2.w};
#pragma unroll
                for (int e2 = 0; e2 < 4; ++e2) {
                    const float2 w0 = *(const float2*)(wq + 2 * e2), w1 = *(const float2*)(wq + 3072 + 2 * e2), w2 = *(const float2*)(wq + 6144 + 2 * e2);
                    const float va = w0.x * bflo(a0[e2]) + w1.x * bflo(a1[e2]) + w2.x * bflo(a2[e2]);
                    const float vb = w0.y * bfhi(a0[e2]) + w1.y * bfhi(a1[e2]) + w2.y * bfhi(a2[e2]);
                    const float ya = siluf(va), yb = siluf(vb);
                    y[c8 * 8 + 2 * e2] = ya; y[c8 * 8 + 2 * e2 + 1] = yb;
                    ss += ya * ya + yb * yb;
                }
            }
            float sc = 1.f;
            if (part < 2) {
                ss += __shfl_xor(ss, 1); ss += __shfl_xor(ss, 2);
                sc = rsqrtf(ss + 1e-6f) * (part == 0 ? 0.08838834764831845f : 1.f);
            }
            bf16_t* dst = (part == 0 ? qs : (part == 1 ? ks : vs)) + i * 136 + dq * 32;
#pragma unroll
            for (int c8 = 0; c8 < 4; ++c8) {
                uint4 o;
                o.x = pack2(y[c8 * 8 + 0] * sc, y[c8 * 8 + 1] * sc); o.y = pack2(y[c8 * 8 + 2] * sc, y[c8 * 8 + 3] * sc);
                o.z = pack2(y[c8 * 8 + 4] * sc, y[c8 * 8 + 5] * sc); o.w = pack2(y[c8 * 8 + 6] * sc, y[c8 * 8 + 7] * sc);
                *(uint4*)(dst + c8 * 8) = o;
                if (part == 0) *(uint4*)(QN + ((size_t)(cidx * 8 + h) * 64 + i) * 128 + dq * 32 + c8 * 8) = o;
            }
        };
        uint4 xa[3][4], xb[3][4];
        ldpart(xa, 0);
        ldpart(xb, 1);
        do_part(xa, 0);
        ldpart(xa, 2);
        do_part(xb, 1);
        do_part(xa, 2);
    }
    if (tid < 128) {
        const int dir = tid >> 6, ii = tid & 63;
        const int rr = row0 + (dir ? 63 - ii : ii);
        const float braw = gates[(size_t)rr * 32 + dir * 8 + h], araw = gates[(size_t)rr * 32 + 16 + dir * 8 + h];
        const float beta = 1.f / (1.f + __expf(-braw));
        const float xx = araw + p.in[I_DTB][dir * 8 + h];
        const float sp = xx > 20.f ? xx : log1pf(__expf(xx));
        const float gval = -__expf(p.in[I_ALOG][dir * 8 + h]) * sp;
        float c = gval;
#pragma unroll
        for (int o = 1; o < 64; o <<= 1) { const float tt = __shfl_up(c, o); if (ii >= o) c += tt; }
        sm_beta[dir * 64 + ii] = beta; sm_gc[dir * 64 + ii] = c;
        sm_su[dir * 64 + ii] = beta; sm_sw[dir * 64 + ii] = beta * __expf(c);
        GC[((size_t)(cidx * 8 + h) * 2 + dir) * 64 + ii] = c;
    }
    BAR_LDS();
    {
#pragma unroll
        for (int i = 0; i < 4; ++i) {
            const int pc = tid + 256 * i, dk = pc >> 3, c8 = (pc & 7) * 8;
            const bf16_t* src = ks + c8 * 136 + dk;
            uint4 o;
            o.x = (u32)src[0] | ((u32)src[136] << 16); o.y = (u32)src[2 * 136] | ((u32)src[3 * 136] << 16);
            o.z = (u32)src[4 * 136] | ((u32)src[5 * 136] << 16); o.w = (u32)src[6 * 136] | ((u32)src[7 * 136] << 16);
            *(uint4*)(KNT + ((size_t)(cidx * 8 + h) * 128 + dk) * 64 + c8) = o;
        }
    }
    {
        f32x4 qk[4];
#pragma unroll
        for (int nb = 0; nb < 4; ++nb) qk[nb] = (f32x4){0.f, 0.f, 0.f, 0.f};
#pragma unroll
        for (int k4 = 0; k4 < 4; ++k4) {
            const bf16x8 aq = *(const bf16x8*)(qs + (16 * w + fr) * 136 + k4 * 32 + fq * 8);
#pragma unroll
            for (int nb = 0; nb < 4; ++nb) {
                const bf16x8 bk = *(const bf16x8*)(ks + (nb * 16 + fr) * 136 + k4 * 32 + fq * 8);
                qk[nb] = mfma16(aq, bk, qk[nb]);
            }
        }
#pragma unroll
        for (int dir = 0; dir < 2; ++dir) {
            const size_t ib = (size_t)(cidx * 8 + h) * 2 + dir;
#pragma unroll
            for (int nb = 0; nb < 4; ++nb)
#pragma unroll
                for (int j = 0; j < 4; ++j) {
                    const int io = 16 * w + 4 * fq + j, jo = nb * 16 + fr;
                    const int ip = dir ? 63 - io : io, jp = dir ? 63 - jo : jo;
                    const float dec = __expf(fminf(sm_gc[dir * 64 + ip] - sm_gc[dir * 64 + jp], 0.f));
                    QKb[(ib * 64 + ip) * 64 + jp] = f2bf((ip >= jp) ? qk[nb][j] * dec : 0.f);
                }
        }
    }
    BAR_LDS();
#pragma unroll 1
    for (int dir = 0; dir < 2; ++dir) {
        const size_t ib = (size_t)(cidx * 8 + h) * 2 + dir;
        {
            f32x4 kk[4];
#pragma unroll
            for (int nb = 0; nb < 4; ++nb) kk[nb] = (f32x4){0.f, 0.f, 0.f, 0.f};
#pragma unroll
            for (int k4 = 0; k4 < 4; ++k4) {
                const bf16x8 ak = *(const bf16x8*)(ks + (16 * w + fr) * 136 + k4 * 32 + fq * 8);
#pragma unroll
                for (int nb = 0; nb < 4; ++nb) {
                    const bf16x8 bk = *(const bf16x8*)(ks + (nb * 16 + fr) * 136 + k4 * 32 + fq * 8);
                    kk[nb] = mfma16(ak, bk, kk[nb]);
                }
            }
#pragma unroll
            for (int nb = 0; nb < 4; ++nb)
#pragma unroll
                for (int j = 0; j < 4; ++j) {
                    const int io = 16 * w + 4 * fq + j, jo = nb * 16 + fr;
                    const int ip = dir ? 63 - io : io, jp = dir ? 63 - jo : jo;
                    const float dec = __expf(fminf(sm_gc[dir * 64 + ip] - sm_gc[dir * 64 + jp], 0.f));
                    Ms[ip * 68 + jp] = (ip > jp) ? sm_beta[dir * 64 + ip] * kk[nb][j] * dec : 0.f;
                }
        }
        BAR_LDS();
        {
            const bool isU = tid < 128;
            const int col = tid & 127;
            const bf16_t* src = isU ? vs : ks;
            const float* scl = (isU ? sm_su : sm_sw) + dir * 64;
            float x[64];
            f32x4 mc[16], mn[16];
            float rc = bf2f(src[(dir ? 63 : 0) * 136 + col]) * scl[0], rn = 0.f;
#pragma unroll
            for (int i = 0; i < 64; ++i) {
                if (i + 1 < 64) {
                    const int pos = dir ? 62 - i : i + 1;
                    rn = bf2f(src[pos * 136 + col]) * scl[i + 1];
#pragma unroll
                    for (int q = 0; q < (i + 4) / 4; ++q) mn[q] = *(const f32x4*)(Ms + (i + 1) * 68 + 4 * q);
                }
                asm volatile("" ::: "memory");
                float a = rc;
#pragma unroll
                for (int j = 0; j < i; ++j) a -= mc[j >> 2][j & 3] * x[j];
                x[i] = a;
                rc = rn;
#pragma unroll
                for (int q = 0; q < (i + 4) / 4; ++q) mc[q] = mn[q];
            }
            BAR_LDS();
            bf16_t* XT = (bf16_t*)Ms;
            if (isU) {
#pragma unroll
                for (int g4 = 0; g4 < 16; ++g4) {
                    uint2 o; o.x = pack2(x[g4 * 4 + 0], x[g4 * 4 + 1]); o.y = pack2(x[g4 * 4 + 2], x[g4 * 4 + 3]);
                    *(uint2*)(XT + col * 68 + g4 * 4) = o;
                }
            } else {
                bf16_t* dst = Wb + (ib * 64) * 128 + col;
#pragma unroll
                for (int i = 0; i < 64; ++i) dst[i * 128] = f2bf(x[i]);
            }
            BAR_LDS();
            {
                bf16_t* dst = UT + (ib * 128) * 64;
#pragma unroll
                for (int i = 0; i < 4; ++i) {
                    const int pc = tid + 256 * i, rw = pc >> 3, c8 = (pc & 7) * 8;
                    const uint2 lo = *(const uint2*)(XT + rw * 68 + c8), hi = *(const uint2*)(XT + rw * 68 + c8 + 4);
                    *(uint4*)(dst + rw * 64 + c8) = make_uint4(lo.x, lo.y, hi.x, hi.y);
                }
            }
        }
        BAR_LDS();
    }
}

DEV void dn_scan_item(const Params& p, int chain, bool sample, char* smem) {
    const int tid = HTID, lane = tid & 63, w = tid >> 6, fr = lane & 15, fq = lane >> 4;
    const int slice = HALF_ID;
    const int dir = chain & 1, h = (chain >> 1) & 7, sq = chain >> 4;
    const int nch = sample ? 64 : 4;
    const int cbase = sample ? 128 + sq * 64 : sq * 4;
    bf16_t* Ss = (bf16_t*)smem;
    bf16_t* VNs = Ss + 64 * 136;
    bf16_t* VSs = VNs + 64 * 72;
    bf16_t* Os = VSs + 64 * 72;
    const bf16_t* QN = (const bf16_t*)(p.ws + R1_QN);
    const bf16_t* KNT = (const bf16_t*)(p.ws + R1_KNT);
    const bf16_t* UT = (const bf16_t*)(p.out);
    const bf16_t* Wb = UT + (size_t)6144 * 128 * 64;
    const bf16_t* QKb = (const bf16_t*)(p.ws + R2_QK);
    const float* GC = (const float*)(p.ws + S_GC);
    bf16_t* OB = (bf16_t*)(p.ws + R2_PB);

    f32x4 sacc[2][4];
#pragma unroll
    for (int rt = 0; rt < 2; ++rt)
#pragma unroll
        for (int ct = 0; ct < 4; ++ct) {
            if (sample) {
                const float* src = p.in[dir ? I_SBB : I_SBF] + (size_t)(sq * 8 + h) * 128 * 128;
#pragma unroll
                for (int j = 0; j < 4; ++j) sacc[rt][ct][j] = src[(size_t)(32 * w + 16 * rt + 4 * fq + j) * 128 + slice * 64 + 16 * ct + fr];
            } else sacc[rt][ct] = (f32x4){0.f, 0.f, 0.f, 0.f};
        }
    BAR_LDS();
#pragma unroll
    for (int rt = 0; rt < 2; ++rt)
#pragma unroll
        for (int ct = 0; ct < 4; ++ct) {
            uint2 o; o.x = pack2(sacc[rt][ct][0], sacc[rt][ct][1]); o.y = pack2(sacc[rt][ct][2], sacc[rt][ct][3]);
            *(uint2*)(Ss + (16 * ct + fr) * 136 + 32 * w + 16 * rt + 4 * fq) = o;
        }
    const int ipA = 16 * w + fr;
    const int posA = dir ? 63 - ipA : ipA;
    const int i0 = 16 * w + 4 * fq;
    struct ScanOps { bf16x8 wf[4], qf[4]; uint2 uf[4]; float4 gc4; float glast; int row0; };
    auto scan_load = [&](ScanOps& o, int s) __attribute__((always_inline)) {
        const int cs = dir ? nch - 1 - s : s;
        const int cidx = cbase + cs, row0 = cidx * 64;
        const size_t ib = (size_t)(cidx * 8 + h) * 2 + dir;
        o.row0 = row0;
#pragma unroll
        for (int k4 = 0; k4 < 4; ++k4) {
            o.wf[k4] = *(const bf16x8*)(Wb + (ib * 64 + ipA) * 128 + k4 * 32 + fq * 8);
            o.qf[k4] = *(const bf16x8*)(QN + ((size_t)(cidx * 8 + h) * 64 + posA) * 128 + k4 * 32 + fq * 8);
        }
#pragma unroll
        for (int ct = 0; ct < 4; ++ct) o.uf[ct] = *(const uint2*)(UT + (ib * 128 + slice * 64 + 16 * ct + fr) * 64 + i0);
        o.gc4 = *(const float4*)(GC + ib * 64 + i0);
        o.glast = GC[ib * 64 + 63];
    };
    int orow_prev = 0;
    ScanOps nxt;
    scan_load(nxt, 0);
#pragma unroll 1
    for (int s = 0; s < nch; ++s) {
        const ScanOps cur = nxt;
        scan_load(nxt, min(s + 1, nch - 1));
        const int row0 = cur.row0;
        bf16x8 qkf[2], knf[2][2];
        {
            const int cidx = row0 >> 6;
            const size_t ib = (size_t)(cidx * 8 + h) * 2 + dir;
#pragma unroll
            for (int k2 = 0; k2 < 2; ++k2) {
                qkf[k2] = *(const bf16x8*)(QKb + (ib * 64 + ipA) * 64 + k2 * 32 + fq * 8);
#pragma unroll
                for (int rt = 0; rt < 2; ++rt)
                    knf[rt][k2] = *(const bf16x8*)(KNT + ((size_t)(cidx * 8 + h) * 128 + 32 * w + 16 * rt + fr) * 64 + k2 * 32 + fq * 8);
            }
        }
        const float glast = cur.glast;
        const float gcv[4] = {cur.gc4.x, cur.gc4.y, cur.gc4.z, cur.gc4.w};
#define wf cur.wf
#define qf cur.qf
#define uf cur.uf
        BAR_LDS();
        if (s > 0) {
#pragma unroll
            for (int i = 0; i < 2; ++i) {
                const int pc = tid + 256 * i, tk = pc >> 3, c8 = (pc & 7) * 8;
                *(uint4*)(OB + ((size_t)dir * NTOK + orow_prev + tk) * 1024 + h * 128 + slice * 64 + c8) = *(const uint4*)(Os + tk * 72 + c8);
            }
        }
        f32x4 wsv[4], qsv[4];
#pragma unroll
        for (int ct = 0; ct < 4; ++ct) { wsv[ct] = (f32x4){0.f, 0.f, 0.f, 0.f}; qsv[ct] = (f32x4){0.f, 0.f, 0.f, 0.f}; }
#pragma unroll
        for (int k4 = 0; k4 < 4; ++k4) {
            bf16x8 sf[4];
#pragma unroll
            for (int ct = 0; ct < 4; ++ct) sf[ct] = *(const bf16x8*)(Ss + (16 * ct + fr) * 136 + k4 * 32 + fq * 8);
            asm volatile("" ::: "memory");
#pragma unroll
            for (int ct = 0; ct < 4; ++ct) {
                wsv[ct] = mfma16(wf[k4], sf[ct], wsv[ct]);
                qsv[ct] = mfma16(qf[k4], sf[ct], qsv[ct]);
            }
        }
        float ek[4], eg[4];
#pragma unroll
        for (int j = 0; j < 4; ++j) { ek[j] = __expf(glast - gcv[j]); eg[j] = __expf(gcv[j]); }
#pragma unroll
        for (int ct = 0; ct < 4; ++ct) {
            float vn[4];
            vn[0] = bflo(uf[ct].x) - wsv[ct][0]; vn[1] = bfhi(uf[ct].x) - wsv[ct][1];
            vn[2] = bflo(uf[ct].y) - wsv[ct][2]; vn[3] = bfhi(uf[ct].y) - wsv[ct][3];
            uint2 o; o.x = pack2(vn[0], vn[1]); o.y = pack2(vn[2], vn[3]);
            *(uint2*)(VNs + (16 * ct + fr) * 72 + i0) = o;
            uint2 o2;
            if (dir == 0) { o2.x = pack2(vn[0] * ek[0], vn[1] * ek[1]); o2.y = pack2(vn[2] * ek[2], vn[3] * ek[3]);
                *(uint2*)(VSs + (16 * ct + fr) * 72 + i0) = o2; }
            else { o2.x = pack2(vn[3] * ek[3], vn[2] * ek[2]); o2.y = pack2(vn[1] * ek[1], vn[0] * ek[0]);
                *(uint2*)(VSs + (16 * ct + fr) * 72 + 60 - i0) = o2; }
        }
        BAR_LDS();
        bf16x8 vnf[4][2], vsf[4][2];
#pragma unroll
        for (int ct = 0; ct < 4; ++ct)
#pragma unroll
            for (int k2 = 0; k2 < 2; ++k2) vnf[ct][k2] = *(const bf16x8*)(VNs + (16 * ct + fr) * 72 + k2 * 32 + fq * 8);
#pragma unroll
        for (int ct = 0; ct < 4; ++ct)
#pragma unroll
            for (int k2 = 0; k2 < 2; ++k2) vsf[ct][k2] = *(const bf16x8*)(VSs + (16 * ct + fr) * 72 + k2 * 32 + fq * 8);
        asm volatile("" ::: "memory");
#pragma unroll
        for (int ct = 0; ct < 4; ++ct) {
            f32x4 oa;
#pragma unroll
            for (int j = 0; j < 4; ++j) oa[j] = qsv[ct][j] * eg[j];
#pragma unroll
            for (int k2 = 0; k2 < 2; ++k2) oa = mfma16(qkf[k2], vnf[ct][k2], oa);
#pragma unroll
            for (int j = 0; j < 4; ++j) {
                const int ip = i0 + j, pos = dir ? 63 - ip : ip;
                Os[pos * 72 + 16 * ct + fr] = f2bf(oa[j]);
            }
        }
        orow_prev = row0;
        const float cd = __expf(glast);
#pragma unroll
        for (int rt = 0; rt < 2; ++rt)
#pragma unroll
            for (int ct = 0; ct < 4; ++ct) {
#pragma unroll
                for (int j = 0; j < 4; ++j) sacc[rt][ct][j] *= cd;
#pragma unroll
                for (int k2 = 0; k2 < 2; ++k2) sacc[rt][ct] = mfma16(knf[rt][k2], vsf[ct][k2], sacc[rt][ct]);
                uint2 o; o.x = pack2(sacc[rt][ct][0], sacc[rt][ct][1]); o.y = pack2(sacc[rt][ct][2], sacc[rt][ct][3]);
                *(uint2*)(Ss + (16 * ct + fr) * 136 + 32 * w + 16 * rt + 4 * fq) = o;
            }
    }
#undef wf
#undef qf
#undef uf
    BAR_LDS();
#pragma unroll
    for (int i = 0; i < 2; ++i) {
        const int pc = tid + 256 * i, tk = pc >> 3, c8 = (pc & 7) * 8;
        *(uint4*)(OB + ((size_t)dir * NTOK + orow_prev + tk) * 1024 + h * 128 + slice * 64 + c8) = *(const uint4*)(Os + tk * 72 + c8);
    }
    if (!sample) {
        float* dst = p.out + (dir ? O_BB : O_BF) + (size_t)(sq * 8 + h) * 128 * 128;
#pragma unroll
        for (int rt = 0; rt < 2; ++rt)
#pragma unroll
            for (int ct = 0; ct < 4; ++ct)
#pragma unroll
                for (int j = 0; j < 4; ++j) dst[(size_t)(32 * w + 16 * rt + 4 * fq + j) * 128 + slice * 64 + 16 * ct + fr] = sacc[rt][ct][j];
    }
}

DEV void dn_final_phase(const Params& p) {
    const int lane = threadIdx.x & 63, wave = threadIdx.x >> 6;
    const bf16_t* OB = (const bf16_t*)(p.ws + R2_PB);
    const bf16_t* PZ = (const bf16_t*)(p.ws + R2_PZ);
    bf16_t* O = (bf16_t*)(p.ws + R3);
    const float* gn = p.in[I_ONORM];
    for (int row = blockIdx.x * 8 + wave; row < NTOK; row += gridDim.x * 8) {
        const int c0 = lane * 16;
        float v[16];
        float ss = 0.f;
#pragma unroll
        for (int hh = 0; hh < 2; ++hh) {
            const uint4 a = *(const uint4*)(OB + (size_t)row * 1024 + c0 + hh * 8);
            const uint4 b = *(const uint4*)(OB + ((size_t)NTOK + row) * 1024 + c0 + hh * 8);
            const u32 aa[4] = {a.x, a.y, a.z, a.w}, bb[4] = {b.x, b.y, b.z, b.w};
#pragma unroll
            for (int e = 0; e < 4; ++e) {
                const float lo = bflo(aa[e]) + bflo(bb[e]), hi = bfhi(aa[e]) + bfhi(bb[e]);
                v[hh * 8 + 2 * e] = lo; v[hh * 8 + 2 * e + 1] = hi;
                ss += lo * lo + hi * hi;
            }
        }
        ss += __shfl_xor(ss, 1); ss += __shfl_xor(ss, 2); ss += __shfl_xor(ss, 4);
        const float rstd = rsqrtf(ss * (1.f / 128.f) + 1e-6f);
#pragma unroll
        for (int hh = 0; hh < 2; ++hh) {
            const uint4 z = *(const uint4*)(PZ + (size_t)row * 1024 + c0 + hh * 8);
            const u32 zz[4] = {z.x, z.y, z.z, z.w};
            u32 o[4];
#pragma unroll
            for (int e = 0; e < 4; ++e) {
                const int d = (c0 + hh * 8 + 2 * e) & 127;
                const float lo = v[hh * 8 + 2 * e] * rstd * gn[d] * siluf(bflo(zz[e]));
                const float hi = v[hh * 8 + 2 * e + 1] * rstd * gn[d + 1] * siluf(bfhi(zz[e]));
                o[e] = pack2(lo, hi);
            }
            *(uint4*)(O + (size_t)row * 2048 + 1024 + c0 + hh * 8) = make_uint4(o[0], o[1], o[2], o[3]);
        }
    }
}

__global__ void __launch_bounds__(512) mega(Params p) {
    cg::grid_group grid = cg::this_grid();
    extern __shared__ __attribute__((aligned(16))) unsigned char dyn_lds[];
    LAS unsigned char* glds = (LAS unsigned char*)dyn_lds;
#define smem ((char*)dyn_lds + HALF_ID * HSMEM)
    int* s_item = (int*)((char*)dyn_lds + STAGE_LDS);
    float* ada = (float*)(p.ws + S_ADA);
    bf16_t* Xb = (bf16_t*)p.out;
    bf16_t* Xlast = (bf16_t*)(p.ws + R3);
    int ph = 0;
    unsigned* gbar = (unsigned*)(p.ws + S_BAR);
    const unsigned my_xcc = xcc_id();
    if (threadIdx.x == 0) __hip_atomic_fetch_add(gbar + 64 * my_xcc, 1u, __ATOMIC_RELAXED, __HIP_MEMORY_SCOPE_AGENT);
    unsigned n_here = 0, n_xcc = 0;
#define SYNC_OR_STOP() do { if (++ph > PHASE_STOP) return; \
        if (ph == 1) { grid.sync(); n_here = __hip_atomic_load(gbar + 64 * my_xcc, __ATOMIC_RELAXED, __HIP_MEMORY_SCOPE_AGENT); \
            _Pragma("unroll") for (int j = 0; j < 8; ++j) n_xcc += __hip_atomic_load(gbar + 64 * j, __ATOMIC_RELAXED, __HIP_MEMORY_SCOPE_AGENT) != 0u; } \
        else grid_barrier(gbar, (unsigned)(ph - 1), n_here, n_xcc, my_xcc); } while (0)

    phase0(p, smem);
    SYNC_OR_STOP();
    modulate_phase<false>(p.in[I_XP], p.in[I_XS], nullptr, p.in[I_NMIX], ada, 0, (bf16_t*)(p.ws + R1));
    SYNC_OR_STOP();
    {
        EpiProj0 e{(bf16_t*)(p.ws + R2_PA), (bf16_t*)(p.ws + R2_VTA), (bf16_t*)(p.ws + R2_PB), (bf16_t*)(p.ws + R2_PZ),
                   (float*)(p.ws + S_GATES), p.out + O_AK, p.out + O_AV};
        g8::gemm_phase(glds, (const bf16_t*)(p.ws + R1), (const bf16_t*)(p.ws + W_ABIN), NTOK, ABNP, DM, e);
    }
    SYNC_OR_STOP();
    for (int it = blockIdx.x * 2 + HALF_ID; it < 3072; it += gridDim.x * 2) dn_prep_item(p, it, smem);
    SYNC_OR_STOP();
    {
        int* ctr0 = (int*)(p.ws + S_CTR);
        int steal = 0;
        for (;;) {
            const int xcd = (int)((my_xcc + (unsigned)steal) & 7u);
            BAR_LDS();
            if (threadIdx.x == 0) *s_item = atomicAdd(ctr0 + xcd * 16, 1);
            BAR_LDS();
            const int q = *s_item;
            if (q >= 264) { if (++steal >= 8) break; continue; }
            if (q < 8) dn_scan_item(p, xcd * 8 + q, true, smem);
            else if (q < 72) dn_scan_item(p, xcd * 64 + (q - 8), false, smem);
            else if (q < 200) attn_item<1>(p, (xcd * 128 + (q - 72)) * 2 + HALF_ID, smem);
            else attn_item<0>(p, (xcd * 64 + (q - 200)) * 2 + HALF_ID, smem);
        }
    }
    SYNC_OR_STOP();
    dn_final_phase(p);
    SYNC_OR_STOP();
    {
        EpiRes<true> e{p.in[I_XP], p.in[I_XS], nullptr, Xb, ada + 2 * 2048};
        g8::gemm_phase(glds, (const bf16_t*)(p.ws + R3), (const bf16_t*)(p.ws + W_ABOUT), NTOK, DM, DM, e);
    }
    SYNC_OR_STOP();
    modulate_phase<true>(nullptr, nullptr, Xb, p.in[I_NMLP], ada, 3, (bf16_t*)(p.ws + R1));
    SYNC_OR_STOP();
    {
        EpiMlp1 e{(bf16_t*)(p.ws + R2)};
        g8::gemm_phase(glds, (const bf16_t*)(p.ws + R1), (const bf16_t*)(p.ws + W_MLPIN), NTOK, DFF, DM, e);
    }
    SYNC_OR_STOP();
    {
        EpiRes<false> e{nullptr, nullptr, Xb, Xb, ada + 5 * 2048};
        g8::gemm_phase(glds, (const bf16_t*)(p.ws + R2), (const bf16_t*)(p.ws + W_MLPOUT), NTOK, DM, DFF, e);
    }
    SYNC_OR_STOP();
    const float* ada1 = ada + 5 * 12288;
    modulate_phase<true>(nullptr, nullptr, Xb, p.in[I_NMIX] + DM, ada1, 0, (bf16_t*)(p.ws + R1));
    SYNC_OR_STOP();
    {
        EpiQkv1 e{(bf16_t*)(p.ws + R2_QKC), (bf16_t*)(p.ws + R2_VTC), p.out + O_CK, p.out + O_CV};
        g8::gemm_phase(glds, (const bf16_t*)(p.ws + R1), (const bf16_t*)(p.ws + W_CQKV), NTOK, 2560, DM, e);
    }
    SYNC_OR_STOP();
    {
        const int vb = (blockIdx.x & 7) * (gridDim.x >> 3) + (blockIdx.x >> 3);
        for (int it = vb * 2 + HALF_ID; it < 4096 + 2048; it += gridDim.x * 2) {
            if (it < 4096) attn_item<3>(p, it, smem); else attn_item<2>(p, it - 4096, smem);
        }
    }
    SYNC_OR_STOP();
    {
        EpiRes<false> e{nullptr, nullptr, Xb, Xb, ada1 + 2 * 2048};
        g8::gemm_phase(glds, (const bf16_t*)(p.ws + R3), (const bf16_t*)(p.ws + W_COUT), NTOK, DM, DM, e);
    }
    SYNC_OR_STOP();
    modulate_phase<true>(nullptr, nullptr, Xb, p.in[I_NMLP] + DM, ada1, 3, (bf16_t*)(p.ws + R1));
    SYNC_OR_STOP();
    {
        EpiMlp1 e{(bf16_t*)(p.ws + R2)};
        g8::gemm_phase(glds, (const bf16_t*)(p.ws + R1), (const bf16_t*)(p.ws + W_MLPIN + SZ_MLP), NTOK, DFF, DM, e);
    }
    SYNC_OR_STOP();
    {
        EpiRes<false> e{nullptr, nullptr, Xb, Xlast, ada1 + 5 * 2048};
        g8::gemm_phase(glds, (const bf16_t*)(p.ws + R2), (const bf16_t*)(p.ws + W_MLPOUT + SZ_MLP), NTOK, DM, DFF, e);
    }
    SYNC_OR_STOP();
    final_norm_phase(Xlast, p.out, p.in[I_FNORM]);
}

extern "C" void kernel_launch(void* const* d_in, const int* in_sizes, int n_in, void* d_out, int out_size, void* d_ws, size_t ws_size,
                              hipStream_t stream) {
    static int grid_blocks = 0;
    if (grid_blocks == 0) {
        int dev = 0, cus = 0, per_cu = 0;
        (void)hipGetDevice(&dev);
        (void)hipDeviceGetAttribute(&cus, hipDeviceAttributeMultiprocessorCount, dev);
        hipError_t ea = hipFuncSetAttribute((const void*)mega, hipFuncAttributeMaxDynamicSharedMemorySize, DYN_LDS);
        (void)hipOccupancyMaxActiveBlocksPerMultiprocessor(&per_cu, (const void*)mega, 512, DYN_LDS);
        if (per_cu < 1) fprintf(stderr, "kernel_launch: occupancy query says %d blocks/CU\n", per_cu);
        grid_blocks = cus;
        if (ea != hipSuccess || n_in != 27 || ws_size < WS_TOTAL || (cus & 7) != 0) {
            fprintf(stderr, "kernel_launch: need 27 inputs and %zu bytes of workspace, got %d / %zu (attr %d, cus %d)\n", (size_t)WS_TOTAL, n_in, ws_size, (int)ea, cus);
            grid_blocks = -1;
        }
    }
    if (grid_blocks < 0) return;
    Params p;
    memset(&p, 0, sizeof(p));
    for (int i = 0; i < 27; ++i) p.in[i] = (const float*)d_in[i];
    p.out = (float*)d_out;
    p.ws = (char*)d_ws;
    (void)hipMemsetAsync((char*)d_ws + S_ADA, 0, 2 * 5 * 12288 * 4 + 8192, stream);
    void* args[] = {&p};
    hipError_t e = hipLaunchCooperativeKernel((const void*)mega, dim3(grid_blocks), dim3(512), args, DYN_LDS, stream);
    if (e != hipSuccess) fprintf(stderr, "cooperative launch failed: %s (grid %d)\n", hipGetErrorString(e), grid_blocks);
}
```
